# Optimizing an MI355X kernel written in HIP

```python
import math
import jax, jax.numpy as jnp
from jax import lax
import numpy as np

D_MODEL = 1024
BATCH = 16
SEQ = 4096
DEPTH = 2

CHUNK = 64
Q_BLOCK = 128
MEM_LEN = 256
D_MIX = D_MODEL
DIFF_HEADS = 4
DIFF_HEAD_DIM = 64
DIFF_V_DIM = 2 * DIFF_HEAD_DIM
D_DIFF_QK = DIFF_HEADS * 2 * DIFF_HEAD_DIM
D_DIFF = DIFF_HEADS * DIFF_V_DIM
MLSTM_HEADS = 4
MLSTM_HEAD_DIM = 64
D_MLSTM = MLSTM_HEADS * MLSTM_HEAD_DIM
CONV_WIDTH = 4
S5_GROUP = 16
D_S5 = D_MIX - D_DIFF - D_MLSTM
S5_GROUPS = D_S5 // S5_GROUP
S5_STATE = 64
XATTN_HEADS = 4
D_FF = 2816
ROPE_THETA = 10000.0
LN_EPS = 1e-5
DN_ALPHA = (2 * DEPTH) ** 0.25
DN_BETA = (8 * DEPTH) ** -0.25
IN_WIDTHS = (D_DIFF_QK, D_DIFF_QK, D_DIFF,
             D_MLSTM, D_MLSTM, D_MLSTM, D_MLSTM,
             MLSTM_HEADS, MLSTM_HEADS,
             D_S5)
D_IN = sum(IN_WIDTHS)

kernel_name = "hybrid_diffattn_mlstm_s5_streaming_encoder"


def split_columns(t, widths):
    out, start = [], 0
    for w in widths:
        out.append(t[..., start:start + w])
        start += w
    return out


def layer_norm(x, g, b):
    xf = x.astype(jnp.float32)
    mu = jnp.mean(xf, -1, keepdims=True)
    var = jnp.mean(jnp.square(xf - mu), -1, keepdims=True)
    y = (xf - mu) * lax.rsqrt(var + LN_EPS)
    return (y * g.astype(jnp.float32) + b.astype(jnp.float32)).astype(x.dtype)


def rms_norm(x, g):
    xf = x.astype(jnp.float32)
    y = xf * lax.rsqrt(jnp.mean(xf * xf, -1, keepdims=True) + LN_EPS)
    return (y * g.astype(jnp.float32)).astype(x.dtype)


def swiglu(x, w_gate, w_up, w_down):
    return (jax.nn.silu(x @ w_gate) * (x @ w_up)) @ w_down


def rope_tables(seq):
    pos = jnp.arange(seq, dtype=jnp.float32)
    inv = ROPE_THETA ** (-jnp.arange(0, DIFF_HEAD_DIM, 2, dtype=jnp.float32) / DIFF_HEAD_DIM)
    ang = pos[:, None] * inv[None, :]
    return jnp.cos(ang), jnp.sin(ang)


def apply_rope(t, cos, sin):
    t1, t2 = jnp.split(t, 2, axis=-1)
    c = cos[None, :, None, None, :]
    s = sin[None, :, None, None, :]
    return jnp.concatenate([t1 * c - t2 * s, t2 * c + t1 * s], -1).astype(t.dtype)


def diff_attention(q, k, v, lam):
    b_, s_ = q.shape[:2]
    nqb = s_ // Q_BLOCK
    scale = DIFF_HEAD_DIM ** -0.5
    k_chunk = jnp.arange(s_) // CHUNK
    qb = jnp.moveaxis(q.reshape(b_, nqb, Q_BLOCK, DIFF_HEADS, 2, DIFF_HEAD_DIM), 1, 0)

    def block(args):
        j, qj = args
        q_chunk = (j * Q_BLOCK + jnp.arange(Q_BLOCK)) // CHUNK
        allowed = k_chunk[None, :] <= q_chunk[:, None]
        s = jnp.einsum('bqhmd,bkhmd->bhmqk', qj, k).astype(jnp.float32) * scale
        s = jnp.where(allowed, s, -jnp.inf)
        p = jax.nn.softmax(s, axis=-1)
        a = p[:, :, 0] - lam * p[:, :, 1]
        return jnp.einsum('bhqk,bkhe->bqhe', a.astype(v.dtype), v)

    out = lax.map(block, (jnp.arange(nqb), qb))
    return jnp.moveaxis(out, 0, 1).reshape(b_, s_, DIFF_HEADS, DIFF_V_DIM)


def causal_conv(x, w, b):
    kw = w.shape[0]
    s_ = x.shape[1]
    xp = jnp.pad(x, ((0, 0), (kw - 1, 0), (0, 0)))
    y = xp[:, 0:s_] * w[0]
    for j in range(1, kw):
        y = y + xp[:, j:j + s_] * w[j]
    return y + b


def mlstm_chunkwise(q, k, v, ig, lf):
    b_, s_, h_, d_ = q.shape
    nc = s_ // CHUNK
    tril = jnp.tril(jnp.ones((CHUNK, CHUNK), bool))

    def to_chunks(t):
        return jnp.moveaxis(t.reshape((b_, nc, CHUNK) + t.shape[2:]), 1, 0)

    def step(carry, xs):
        c_st, n_st, m_st = carry
        qc, kc, vc, ic, fc = xs
        bcum = jnp.cumsum(fc, axis=1)
        b_last = bcum[:, -1]
        log_d = bcum[:, :, None, :] - bcum[:, None, :, :] + ic[:, None, :, :]
        log_d = jnp.where(tril[None, :, :, None], log_d, -jnp.inf)
        log_inter = bcum + m_st[:, None, :]
        m_t = jnp.maximum(log_inter, jnp.max(log_d, axis=2))
        dmat = jnp.exp(log_d - m_t[:, :, None, :])
        scores = jnp.einsum('bthd,bshd->btsh', qc, kc) * dmat
        inter = jnp.exp(log_inter - m_t)
        num = (jnp.einsum('btsh,bshd->bthd', scores, vc)
               + inter[..., None] * jnp.einsum('bhvk,bthk->bthv', c_st, qc))
        den = jnp.sum(scores, axis=2) + inter * jnp.einsum('bhk,bthk->bth', n_st, qc)
        den = jnp.maximum(jnp.abs(den), jnp.exp(-m_t))
        h = num / den[..., None]
        m_new = jnp.maximum(b_last + m_st, jnp.max(b_last[:, None] - bcum + ic, axis=1))
        w = jnp.exp(b_last[:, None] - bcum + ic - m_new[:, None])
        decay = jnp.exp(b_last + m_st - m_new)
        c_new = decay[..., None, None] * c_st + jnp.einsum('bshv,bshk->bhvk', vc * w[..., None], kc)
        n_new = decay[..., None] * n_st + jnp.einsum('bsh,bshk->bhk', w, kc)
        return (c_new, n_new, m_new), h

    init = (jnp.zeros((b_, h_, d_, d_), jnp.float32),
            jnp.zeros((b_, h_, d_), jnp.float32),
            jnp.zeros((b_, h_), jnp.float32))
    _, h = lax.scan(step, init, tuple(to_chunks(t) for t in (q, k, v, ig, lf)))
    return jnp.moveaxis(h, 0, 1).reshape(b_, s_, h_, d_)


def s5_layer(u, a_re, a_im, log_step, b_re, b_im, c_re, c_im, d_skip, glu_w, glu_b):
    b_, s_, _ = u.shape
    f32 = jnp.float32
    uf = u.astype(f32).reshape(b_, s_, S5_GROUPS, S5_GROUP)
    lam = lax.complex(a_re.astype(f32), a_im.astype(f32))
    step = jnp.exp(log_step.astype(f32))[:, None]
    lam_bar = jnp.exp(lam * step)
    b_mat = lax.complex(b_re.astype(f32), b_im.astype(f32))
    b_bar = ((lam_bar - 1.0) / lam)[..., None] * b_mat
    bu = jnp.einsum('bsgc,gpc->bsgp', uf.astype(jnp.complex64), b_bar)

    def combine(left, right):
        a_l, x_l = left
        a_r, x_r = right
        return a_r * a_l, a_r * x_l + x_r

    a_seq = jnp.broadcast_to(lam_bar, (s_,) + lam_bar.shape)[None]
    _, states = lax.associative_scan(combine, (a_seq, bu), axis=1)
    c_mat = lax.complex(c_re.astype(f32), c_im.astype(f32))
    y = (jnp.einsum('bsgp,gcp->bsgc', states, c_mat).real
         + d_skip.astype(f32).reshape(S5_GROUPS, S5_GROUP) * uf)
    y = jax.nn.gelu(y.reshape(b_, s_, D_S5))
    y = y * jax.nn.sigmoid(y @ glu_w.astype(f32) + glu_b.astype(f32))
    return y.astype(u.dtype)


def hybrid_mix(x, cos, sin, lambda_init, w_in, conv_w, conv_b, mlstm_gate_b, mlstm_norm_g,
               diff_lambda, diff_norm_g, s5_a_re, s5_a_im, s5_log_step, s5_b_re, s5_b_im,
               s5_c_re, s5_c_im, s5_d, s5_glu_w, s5_glu_b, w_out):
    b_, s_, _ = x.shape
    f32 = jnp.float32
    proj = x @ w_in
    dq, dk, dv, mq, mk, mv, mo, mi, mf, su = split_columns(proj, IN_WIDTHS)

    dq = apply_rope(dq.reshape(b_, s_, DIFF_HEADS, 2, DIFF_HEAD_DIM), cos, sin)
    dk = apply_rope(dk.reshape(b_, s_, DIFF_HEADS, 2, DIFF_HEAD_DIM), cos, sin)
    dv = dv.reshape(b_, s_, DIFF_HEADS, DIFF_V_DIM)
    lq1, lk1, lq2, lk2 = [diff_lambda[i].astype(f32) for i in range(4)]
    lam = jnp.exp(jnp.sum(lq1 * lk1)) - jnp.exp(jnp.sum(lq2 * lk2)) + lambda_init
    a_out = diff_attention(dq, dk, dv, lam)
    a_out = rms_norm(a_out, diff_norm_g) * (1.0 - lambda_init)
    a_out = a_out.reshape(b_, s_, D_DIFF).astype(x.dtype)

    qk = jax.nn.silu(causal_conv(jnp.concatenate([mq, mk], -1), conv_w, conv_b))
    mq, mk = qk[..., :D_MLSTM], qk[..., D_MLSTM:]
    shp = (b_, s_, MLSTM_HEADS, MLSTM_HEAD_DIM)
    q = mq.reshape(shp).astype(f32)
    k = mk.reshape(shp).astype(f32) * (MLSTM_HEAD_DIM ** -0.5)
    v = mv.reshape(shp).astype(f32)
    gb = mlstm_gate_b.astype(f32)
    ig = mi.astype(f32) + gb[:MLSTM_HEADS]
    lf = jax.nn.log_sigmoid(mf.astype(f32) + gb[MLSTM_HEADS:])
    h = mlstm_chunkwise(q, k, v, ig, lf)
    h = rms_norm(h, mlstm_norm_g.reshape(MLSTM_HEADS, MLSTM_HEAD_DIM))
    b_out = (jax.nn.sigmoid(mo.astype(f32)) * h.reshape(b_, s_, D_MLSTM)).astype(x.dtype)

    c_out = s5_layer(su, s5_a_re, s5_a_im, s5_log_step, s5_b_re, s5_b_im,
                     s5_c_re, s5_c_im, s5_d, s5_glu_w, s5_glu_b)

    return jnp.concatenate([a_out, b_out, c_out.astype(x.dtype)], -1) @ w_out


def memory_cross_attention(x, mem, wq, wkv, wo):
    b_, s_, _ = x.shape
    m_ = mem.shape[1]
    hd = D_MODEL // XATTN_HEADS
    q = (x @ wq).reshape(b_, s_, XATTN_HEADS, hd)
    kv = mem @ wkv
    k = kv[..., :D_MODEL].reshape(b_, m_, XATTN_HEADS, hd)
    v = kv[..., D_MODEL:].reshape(b_, m_, XATTN_HEADS, hd)
    s = jnp.einsum('bqhd,bmhd->bhqm', q, k).astype(jnp.float32) * (hd ** -0.5)
    p = jax.nn.softmax(s, axis=-1).astype(v.dtype)
    o = jnp.einsum('bhqm,bmhd->bqhd', p, v).reshape(b_, s_, D_MODEL)
    return o @ wo


def setup_inputs(seed: int = 0) -> dict:
    key = jax.random.key(seed)
    ks = iter(jax.random.split(key, 40))
    f32 = jnp.float32

    def normal(shape, scale):
        return scale * jax.random.normal(next(ks), shape, f32)

    x = normal((BATCH, SEQ, D_MODEL), 1.0)
    mem = normal((BATCH, MEM_LEN, D_MODEL), 1.0)
    ffn_w_gate = normal((DEPTH, 2, D_MODEL, D_FF), D_MODEL ** -0.5)
    ffn_w_up = normal((DEPTH, 2, D_MODEL, D_FF), D_MODEL ** -0.5)
    ffn_w_down = normal((DEPTH, 2, D_FF, D_MODEL), DN_BETA * D_FF ** -0.5)
    ln_g = 1.0 + normal((DEPTH, 4, D_MODEL), 0.02)
    ln_b = normal((DEPTH, 4, D_MODEL), 0.02)
    w_in = normal((DEPTH, D_MODEL, D_IN), D_MODEL ** -0.5)
    conv_w = normal((DEPTH, CONV_WIDTH, 2 * D_MLSTM), CONV_WIDTH ** -0.5)
    conv_b = normal((DEPTH, 2 * D_MLSTM), 0.02)
    f_bias = jnp.linspace(3.0, 6.0, MLSTM_HEADS, dtype=f32)
    mlstm_gate_b = jnp.concatenate([normal((DEPTH, MLSTM_HEADS), 0.1),
                                    f_bias + normal((DEPTH, MLSTM_HEADS), 0.1)], -1)
    mlstm_norm_g = 1.0 + normal((DEPTH, D_MLSTM), 0.02)
    diff_lambda = normal((DEPTH, 4, DIFF_HEAD_DIM), 0.1)
    diff_norm_g = 1.0 + normal((DEPTH, DIFF_V_DIM), 0.02)
    n_idx = jnp.arange(S5_STATE, dtype=f32)
    s5_a_re = -0.5 + normal((DEPTH, S5_GROUPS, S5_STATE), 0.01)
    s5_a_im = jnp.pi * n_idx + normal((DEPTH, S5_GROUPS, S5_STATE), 0.01)
    s5_log_step = jax.random.uniform(next(ks), (DEPTH, S5_GROUPS), f32,
                                     math.log(1e-3), math.log(1e-1))
    s5_b_re = normal((DEPTH, S5_GROUPS, S5_STATE, S5_GROUP), (2 * S5_GROUP) ** -0.5)
    s5_b_im = normal((DEPTH, S5_GROUPS, S5_STATE, S5_GROUP), (2 * S5_GROUP) ** -0.5)
    s5_c_re = normal((DEPTH, S5_GROUPS, S5_GROUP, S5_STATE), (2 * S5_STATE) ** -0.5)
    s5_c_im = normal((DEPTH, S5_GROUPS, S5_GROUP, S5_STATE), (2 * S5_STATE) ** -0.5)
    s5_d = normal((DEPTH, D_S5), 1.0)
    s5_glu_w = normal((DEPTH, D_S5, D_S5), D_S5 ** -0.5)
    s5_glu_b = normal((DEPTH, D_S5), 0.02)
    w_out = normal((DEPTH, D_MIX, D_MODEL), DN_BETA * D_MIX ** -0.5)
    xattn_wq = normal((DEPTH, D_MODEL, D_MODEL), D_MODEL ** -0.5)
    xattn_wkv = normal((DEPTH, D_MODEL, 2 * D_MODEL), D_MODEL ** -0.5)
    xattn_wo = normal((DEPTH, D_MODEL, D_MODEL), DN_BETA * D_MODEL ** -0.5)
    return {"x": x, "mem": mem, "ffn_w_gate": ffn_w_gate, "ffn_w_up": ffn_w_up,
            "ffn_w_down": ffn_w_down, "ln_g": ln_g, "ln_b": ln_b, "w_in": w_in,
            "conv_w": conv_w, "conv_b": conv_b, "mlstm_gate_b": mlstm_gate_b,
            "mlstm_norm_g": mlstm_norm_g, "diff_lambda": diff_lambda,
            "diff_norm_g": diff_norm_g, "s5_a_re": s5_a_re, "s5_a_im": s5_a_im,
            "s5_log_step": s5_log_step, "s5_b_re": s5_b_re, "s5_b_im": s5_b_im,
            "s5_c_re": s5_c_re, "s5_c_im": s5_c_im, "s5_d": s5_d, "s5_glu_w": s5_glu_w,
            "s5_glu_b": s5_glu_b, "w_out": w_out, "xattn_wq": xattn_wq,
            "xattn_wkv": xattn_wkv, "xattn_wo": xattn_wo}


def reference(x, mem, ffn_w_gate, ffn_w_up, ffn_w_down, ln_g, ln_b, w_in, conv_w, conv_b,
              mlstm_gate_b, mlstm_norm_g, diff_lambda, diff_norm_g, s5_a_re, s5_a_im,
              s5_log_step, s5_b_re, s5_b_im, s5_c_re, s5_c_im, s5_d, s5_glu_w, s5_glu_b,
              w_out, xattn_wq, xattn_wkv, xattn_wo):
    cos, sin = rope_tables(x.shape[1])
    for l in range(DEPTH):
        lambda_init = 0.8 - 0.6 * math.exp(-0.3 * l)
        h = swiglu(x, ffn_w_gate[l, 0], ffn_w_up[l, 0], ffn_w_down[l, 0])
        x = layer_norm(DN_ALPHA * x + 0.5 * h, ln_g[l, 0], ln_b[l, 0])
        h = hybrid_mix(x, cos, sin, lambda_init, w_in[l], conv_w[l], conv_b[l],
                       mlstm_gate_b[l], mlstm_norm_g[l], diff_lambda[l], diff_norm_g[l],
                       s5_a_re[l], s5_a_im[l], s5_log_step[l], s5_b_re[l], s5_b_im[l],
                       s5_c_re[l], s5_c_im[l], s5_d[l], s5_glu_w[l], s5_glu_b[l], w_out[l])
        x = layer_norm(DN_ALPHA * x + h, ln_g[l, 1], ln_b[l, 1])
        h = memory_cross_attention(x, mem, xattn_wq[l], xattn_wkv[l], xattn_wo[l])
        x = layer_norm(DN_ALPHA * x + h, ln_g[l, 2], ln_b[l, 2])
        h = swiglu(x, ffn_w_gate[l, 1], ffn_w_up[l, 1], ffn_w_down[l, 1])
        x = layer_norm(DN_ALPHA * x + 0.5 * h, ln_g[l, 3], ln_b[l, 3])
    return x
```

```cpp
#include <hip/hip_runtime.h>
#include <hip/hip_cooperative_groups.h>
#include <cstdio>
#include <cstdint>
namespace cg = cooperative_groups;
__device__ __forceinline__ int tidx() { int t = threadIdx.x; asm volatile("" : "+v"(t)); return t; }
__device__ __forceinline__ int bidx() { int t = blockIdx.x; asm volatile("" : "+s"(t)); return t; }
__device__ __forceinline__ int gdim() { int t = gridDim.x; asm volatile("" : "+s"(t)); return t; }
__device__ __forceinline__ int lnd(int v) { asm volatile("" : "+s"(v)); return v; }
namespace pg8 {
#define PG8_LAS __attribute__((address_space(3)))
typedef unsigned short bf16_t;
typedef short bf16x8 __attribute__((ext_vector_type(8)));
typedef float f32x4 __attribute__((ext_vector_type(4)));
typedef unsigned u32x4 __attribute__((ext_vector_type(4)));
constexpr int BM = 256, BK = 64, HALF = 128, HTB = HALF * BK * 2  , STAGE_BYTES = 8 * HTB, NXCD = 8, WGM = 8;

__host__ __device__ __forceinline__ int lds_byte(int r, int c) { const int st = (r >> 4) * 2 + (c >> 5), rr = r & 15, cc = c & 31, ob = rr * 64 + cc * 2; return st * 1024 + (ob ^ (((ob >> 9) & 1) << 5)); }
__host__ __device__ __forceinline__ void stage_rc(int b, int& R, int& C) { const int st = b / 1024, sb = b % 1024, swz = sb ^ (((sb >> 9) & 1) << 5); R = (st >> 1) * 16 + swz / 64; C = (st & 1) * 32 + (swz % 64) / 2; }
__host__ __device__ __forceinline__ int perm32(int rho) { const int n = rho >> 4, i = rho & 15; return 8 * (i >> 2) + 4 * n + (i & 3); }

struct Unit { int pm, pn; };
struct Gemm { const bf16_t* A; const bf16_t* Bt; int M, N, K, lda, ldb; };

struct StaticOrder {
    int nM, nN, nwg, G, c;
    __host__ __device__ void init(int M, int N, int G_, int c_) { nM = M / BM; nN = N / BM; nwg = nM * nN; G = G_; c = c_; }
    __host__ __device__ bool next(int i, Unit& u) const {
        const long L = (long)i * G + c; if (L >= nwg) return false;
        int wgid = (int)L; { const int q = nwg / NXCD, r = nwg % NXCD, xcd = wgid % NXCD, off = wgid / NXCD; wgid = (xcd < r ? xcd * (q + 1) : r * (q + 1) + (xcd - r) * q) + off; }
        const int nig = WGM * nN, gid = wgid / nig, fm = gid * WGM, gsz = (nM - fm) < WGM ? (nM - fm) : WGM;
        u.pm = fm + ((wgid % nig) % gsz); u.pn = (wgid % nig) / gsz; return true;
    }
    __device__ __forceinline__ void a_ready(const Unit&) const {}
    __device__ __forceinline__ void done(const Unit&) const {}
};

__device__ __forceinline__ unsigned cvt_pk_bf16(float lo, float hi) { unsigned r; asm volatile("v_cvt_pk_bf16_f32 %0, %1, %2" : "=v"(r) : "v"(lo), "v"(hi)); return r; }
typedef float f32x2 __attribute__((ext_vector_type(2)));
typedef _Float16 f16x8_t __attribute__((ext_vector_type(8)));
template <bool F16> __device__ __forceinline__ f32x4 mma16(bf16x8 a, bf16x8 b, f32x4 c) {
    if constexpr (F16) return __builtin_amdgcn_mfma_f32_16x16x32_f16(__builtin_bit_cast(f16x8_t, a), __builtin_bit_cast(f16x8_t, b), c, 0, 0, 0);
    else return __builtin_amdgcn_mfma_f32_16x16x32_bf16(a, b, c, 0, 0, 0);
}
template <class Epi, class Sched, bool ALIGN_EPI = false, bool SP2 = false, bool F16 = false>
__device__ __forceinline__ void gemm_phase(PG8_LAS unsigned char* lds, const Gemm g, const Sched& S, const Epi& E) {
    const int tid = tidx(), wid = __builtin_amdgcn_readfirstlane(tid >> 6), lane = tid & 63, wr = wid >> 2, wc = wid & 3, fr = lane & 15, fq = lane >> 4;
    const int K = g.K, nt = K / BK, lda = g.lda, ldb = g.ldb;
    unsigned voffA[2], voffB[2];
#pragma unroll
    for (int i = 0; i < 2; ++i) { int R, C; stage_rc(tid * 16 + i * 8192, R, C); const int Rb = Epi::PERM ? ((R & ~31) + perm32(R & 31)) : R;
        voffA[i] = (unsigned)(R * lda + C) * 2u; voffB[i] = (unsigned)(Rb * ldb + C) * 2u; }
    const size_t kstep = (size_t)(BK * 2);
    const size_t hstepA = (size_t)HALF * lda * 2, hstepB = (size_t)HALF * ldb * 2;
    const size_t tstepA = 2 * hstepA, tstepB = 2 * hstepB;
    const unsigned ldsw = (unsigned)wid * 1024u;
    const int aoff = lds_byte(wr * 64 + fr, fq * 8), boff = lds_byte(wc * 32 + fr, fq * 8);
#define PG8_SA(b, h) (((b) * 2 + (h)) * HTB)
#define PG8_SB(b, h) ((4 + (b) * 2 + (h)) * HTB)
#define PG8_STAGE(bufoff, gbase, voff) do { _Pragma("unroll") for (int _i = 0; _i < 2; ++_i) \
        __builtin_amdgcn_global_load_lds((const unsigned*)((const char*)(gbase) + (voff)[_i]), (PG8_LAS unsigned*)(lds + (bufoff) + ldsw + _i * 8192), 16, 0, 0); } while (0)
#define PG8_LDA(dst, b, h) do { _Pragma("unroll") for (int m = 0; m < 4; ++m) _Pragma("unroll") for (int k = 0; k < 2; ++k) dst[m][k] = *(const PG8_LAS bf16x8*)(lds + PG8_SA(b, h) + aoff + m * 2048 + k * 1024); } while (0)
#define PG8_LDB(dst, b, h) do { _Pragma("unroll") for (int n = 0; n < 2; ++n) _Pragma("unroll") for (int k = 0; k < 2; ++k) dst[n][k] = *(const PG8_LAS bf16x8*)(lds + PG8_SB(b, h) + boff + n * 2048 + k * 1024); } while (0)
#define PG8_MMA(ai, bj, At, Bt) do { __builtin_amdgcn_s_setprio(1); _Pragma("unroll") for (int m = 0; m < 4; ++m) _Pragma("unroll") for (int n = 0; n < 2; ++n) _Pragma("unroll") for (int k = 0; k < 2; ++k) \
        acc[ai][bj][m][n] = mma16<F16>(Bt[n][k], At[m][k], acc[ai][bj][m][n]); __builtin_amdgcn_s_setprio(0); } while (0)
#define PG8_WAIT_V(n) asm volatile("s_waitcnt vmcnt(" #n ")" ::: "memory")
#define PG8_WAIT_L(n) asm volatile("s_waitcnt lgkmcnt(" #n ")" ::: "memory")
#define PG8_BAR __builtin_amdgcn_s_barrier()
#define PG8_SCHED __builtin_amdgcn_sched_barrier(0)
    Unit cur, nxt; int ui = 0;
    if (!S.next(0, cur)) return;
    f32x4 acc[2][2][4][2];
#pragma unroll
    for (int a = 0; a < 2; ++a)
#pragma unroll
        for (int b = 0; b < 2; ++b)
#pragma unroll
            for (int m = 0; m < 4; ++m)
#pragma unroll
                for (int n = 0; n < 2; ++n) acc[a][b][m][n] = (f32x4){0.f, 0.f, 0.f, 0.f};
    bf16x8 At[4][2], B0[2][2], B1[2][2];
    const char* cA = (const char*)g.A + (size_t)cur.pm * tstepA; const char* cB = (const char*)g.Bt + (size_t)cur.pn * tstepB;
    S.a_ready(cur);
    if constexpr (SP2) {
        PG8_STAGE(PG8_SB(0, 0), cB, voffB); PG8_STAGE(PG8_SB(0, 1), cB + hstepB, voffB); PG8_STAGE(PG8_SA(0, 0), cA, voffA); PG8_STAGE(PG8_SA(0, 1), cA + hstepA, voffA);
        if (wr == 1) PG8_BAR;
        PG8_WAIT_V(2); PG8_BAR;
        PG8_STAGE(PG8_SB(1, 0), cB + kstep, voffB); PG8_STAGE(PG8_SA(1, 0), cA + kstep, voffA); PG8_STAGE(PG8_SB(1, 1), cB + hstepB + kstep, voffB);
        PG8_WAIT_V(6); PG8_BAR;
    } else {
        PG8_STAGE(PG8_SB(0, 0), cB, voffB); PG8_STAGE(PG8_SA(0, 0), cA, voffA); PG8_STAGE(PG8_SB(0, 1), cB + hstepB, voffB); PG8_STAGE(PG8_SA(0, 1), cA + hstepA, voffA);
        if (wr == 1) PG8_BAR;
        PG8_WAIT_V(4); PG8_BAR;
        PG8_STAGE(PG8_SB(1, 0), cB + kstep, voffB); PG8_STAGE(PG8_SA(1, 0), cA + kstep, voffA); PG8_STAGE(PG8_SB(1, 1), cB + hstepB + kstep, voffB);
        PG8_WAIT_V(6); PG8_BAR;
    }
    for (;;) {
        const bool has_next = S.next(ui + 1, nxt);
        const char* nA = has_next ? (const char*)g.A + (size_t)nxt.pm * tstepA : cA; const char* nB = has_next ? (const char*)g.Bt + (size_t)nxt.pn * tstepB : cB;
        for (int t = 0; t < nt; t += 2) {
            const bool last = (t == nt - 2);
            const char* a1 = cA + (size_t)(t + 1) * kstep;
            const char* a2 = last ? nA : cA + (size_t)(t + 2) * kstep; const char* b2 = last ? nB : cB + (size_t)(t + 2) * kstep;
            const char* a3 = a2 + kstep; const char* b3 = b2 + kstep;
            if (last && has_next) S.a_ready(nxt);
            if constexpr (SP2) {
            PG8_LDB(B0, 0, 0); PG8_LDB(B1, 0, 1); PG8_SCHED; PG8_LDA(At, 0, 0); PG8_STAGE(PG8_SA(1, 1), a1 + hstepA, voffA);
            PG8_WAIT_V(8); PG8_WAIT_L(0); PG8_BAR; PG8_MMA(0, 0, At, B0); PG8_MMA(0, 1, At, B1); PG8_BAR; PG8_SCHED;
            PG8_LDA(At, 0, 1); PG8_STAGE(PG8_SB(0, 0), b2, voffB); PG8_STAGE(PG8_SB(0, 1), b2 + hstepB, voffB); PG8_STAGE(PG8_SA(0, 0), a2, voffA);
            PG8_WAIT_V(8); PG8_WAIT_L(0); PG8_BAR; PG8_MMA(1, 0, At, B0); PG8_MMA(1, 1, At, B1); PG8_BAR; PG8_SCHED;
            PG8_LDB(B0, 1, 0); PG8_LDB(B1, 1, 1); PG8_SCHED; PG8_LDA(At, 1, 0); PG8_STAGE(PG8_SA(0, 1), a2 + hstepA, voffA);
            PG8_WAIT_V(8); PG8_WAIT_L(0); PG8_BAR; PG8_MMA(0, 0, At, B0); PG8_MMA(0, 1, At, B1); PG8_BAR; PG8_SCHED;
            PG8_LDA(At, 1, 1); PG8_STAGE(PG8_SB(1, 0), b3, voffB); PG8_STAGE(PG8_SB(1, 1), b3 + hstepB, voffB); PG8_STAGE(PG8_SA(1, 0), a3, voffA);
            PG8_WAIT_V(8); PG8_WAIT_L(0); PG8_BAR; PG8_MMA(1, 0, At, B0); PG8_MMA(1, 1, At, B1); PG8_BAR; PG8_SCHED;
            } else {
            PG8_LDB(B0, 0, 0); PG8_SCHED; PG8_LDA(At, 0, 0); PG8_STAGE(PG8_SA(1, 1), a1 + hstepA, voffA);
            PG8_WAIT_L(8); PG8_BAR; PG8_WAIT_L(0); PG8_MMA(0, 0, At, B0); PG8_BAR; PG8_SCHED;
            PG8_LDB(B1, 0, 1); PG8_STAGE(PG8_SB(0, 0), b2, voffB);
            PG8_BAR; PG8_WAIT_L(0); PG8_MMA(0, 1, At, B1); PG8_BAR;
            PG8_LDA(At, 0, 1); PG8_STAGE(PG8_SA(0, 0), a2, voffA);
            PG8_BAR; PG8_WAIT_L(0); PG8_MMA(1, 0, At, B0); PG8_BAR; PG8_SCHED;
            PG8_STAGE(PG8_SB(0, 1), b2 + hstepB, voffB);
            PG8_WAIT_V(6); PG8_BAR; PG8_MMA(1, 1, At, B1); PG8_BAR;
            PG8_LDB(B0, 1, 0); PG8_SCHED; PG8_LDA(At, 1, 0); PG8_STAGE(PG8_SA(0, 1), a2 + hstepA, voffA);
            PG8_WAIT_L(8); PG8_BAR; PG8_WAIT_L(0); PG8_MMA(0, 0, At, B0); PG8_BAR; PG8_SCHED;
            PG8_LDB(B1, 1, 1); PG8_STAGE(PG8_SB(1, 0), b3, voffB);
            PG8_BAR; PG8_WAIT_L(0); PG8_MMA(0, 1, At, B1); PG8_BAR;
            PG8_LDA(At, 1, 1); PG8_STAGE(PG8_SA(1, 0), a3, voffA);
            PG8_BAR; PG8_WAIT_L(0); PG8_MMA(1, 0, At, B0); PG8_BAR; PG8_SCHED;
            PG8_STAGE(PG8_SB(1, 1), b3 + hstepB, voffB);
            PG8_WAIT_V(6); PG8_BAR; PG8_MMA(1, 1, At, B1); PG8_BAR;
            }
        }
        if constexpr (ALIGN_EPI) { if (wr == 0) PG8_BAR; }
        if constexpr (!Epi::AFTER_DRAIN) { E(acc, cur, wr, wc, fr, fq); S.done(cur); }
        if (!has_next) break;
#pragma unroll
        for (int a = 0; a < 2; ++a)
#pragma unroll
            for (int b = 0; b < 2; ++b)
#pragma unroll
                for (int m = 0; m < 4; ++m)
#pragma unroll
                    for (int n = 0; n < 2; ++n) acc[a][b][m][n] = (f32x4){0.f, 0.f, 0.f, 0.f};
        cur = nxt; cA = nA; cB = nB; ++ui;
        if constexpr (ALIGN_EPI) { if (wr == 1) PG8_BAR; }
    }
    PG8_WAIT_V(0);
    if constexpr (!ALIGN_EPI) { if (wr == 0) PG8_BAR; }
    PG8_BAR;
    if constexpr (Epi::AFTER_DRAIN) { E.fused(acc, cur, wr, wc, fr, fq, lds, wid, lane); S.done(cur); }
#undef PG8_SA
#undef PG8_SB
#undef PG8_STAGE
#undef PG8_LDA
#undef PG8_LDB
#undef PG8_MMA
#undef PG8_WAIT_V
#undef PG8_WAIT_L
#undef PG8_BAR
#undef PG8_SCHED
}
}

#define LAS __attribute__((address_space(3)))
typedef unsigned short bf16;
typedef unsigned v4u __attribute__((ext_vector_type(4)));
typedef unsigned v2u __attribute__((ext_vector_type(2)));
typedef float f32x4 __attribute__((ext_vector_type(4)));
typedef float f32x2 __attribute__((ext_vector_type(2)));
typedef short bf16x8 __attribute__((ext_vector_type(8)));
using pg8::Unit;

constexpr int SEQ = 4096, NB = 16, DM = 1024, MT = NB * SEQ, DFF = 2816, DINW = 2824, NPJ = 2816;
constexpr float ALPHA = 1.41421356237309515f, EPS = 1e-5f, LOG2E = 1.4426950408889634f;
constexpr size_t MiB = 1u << 20;
constexpr size_t WS_ROPE = 1 * MiB, WS_GATES = 2 * MiB, WS_WG = 4 * MiB, WS_MEMB = 5 * MiB, WS_W = 16 * MiB, WS_TF = 68 * MiB, WS_EM = 104 * MiB,
    WS_KX = 112 * MiB, WS_VTX = 120 * MiB, WS_XB = 128 * MiB, WS_CAT = 256 * MiB, WS_HP = 384 * MiB, WS_Y = 736 * MiB,
    WS_NST = 992 * MiB, WS_AB = 993 * MiB, WS_MS = 993 * MiB + 512 * 1024, WS_EOUT = 994 * MiB, WS_POW = 1002 * MiB, WS_BBAR = 1004 * MiB,
    WS_KTAB = 1005 * MiB, WS_LAML = 1006 * MiB, WS_END = 1009 * MiB;
constexpr int POW_L = 147456, BBAR_L = 32768, LAML_L = 2048;
constexpr size_t WO_GU1 = 0, WO_D1 = WO_GU1 + 5632u * 1024, WO_GU2 = WO_D1 + 1024u * 2816, WO_D2 = WO_GU2 + 5632u * 1024, WO_IN = WO_D2 + 1024u * 2816,
    WO_OUT = WO_IN + 3072u * 1024, WO_Q = WO_OUT + 1024u * 1024, WO_KV = WO_Q + 1024u * 1024, WO_O = WO_KV + 2048u * 1024, WO_GLU = WO_O + 1024u * 1024,
    WO_END = WO_GLU + 256u * 256;
static_assert(WO_END * 2 <= 52 * MiB, "weights fit");
constexpr size_t OUT_VT = 0, OUT_C = 64 * MiB, OUT_SUX = 128 * MiB, OUT_YS5 = 164 * MiB;
constexpr size_t WS_RSTAT = 1007 * MiB, WS_RSTID = 1007 * MiB + 512 * 1024, WS_ONES = 1008 * MiB, WS_ZEROS = 1008 * MiB + 4096;
constexpr size_t WS_CC = 65536, CC_L = 30720;
constexpr int CC_GU1 = 0, CC_IN = 5632, CC_Q = 8704, CC_GU2 = 9728, CC_N = 15360;
constexpr size_t WS_STATP = 128 * MiB;
constexpr int LDS_BYTES = 147456;

struct Args { const float* in[28]; float* out; unsigned char* ws; };
typedef const __attribute__((address_space(4))) Args CArgs;
__device__ __forceinline__ CArgs* kargs() { CArgs* p = (CArgs*)__builtin_amdgcn_kernarg_segment_ptr(); asm volatile("" : "+s"(p)); return p; }

__device__ __forceinline__ unsigned pkbf(float lo, float hi) { return pg8::cvt_pk_bf16(lo, hi); }
__device__ __forceinline__ float bf2f(unsigned short b) { return __uint_as_float(((unsigned)b) << 16); }
__device__ __forceinline__ float bflo(unsigned w) { return __uint_as_float(w << 16); }
__device__ __forceinline__ float bfhi(unsigned w) { return __uint_as_float(w & 0xffff0000u); }
typedef _Float16 h16x2 __attribute__((ext_vector_type(2)));
__device__ __forceinline__ unsigned pkh(float lo, float hi) { h16x2 v; v.x = (_Float16)lo; v.y = (_Float16)hi; return __builtin_bit_cast(unsigned, v); }
__device__ __forceinline__ float hlo(unsigned w) { return (float)__builtin_bit_cast(h16x2, w).x; }
__device__ __forceinline__ float hhi(unsigned w) { return (float)__builtin_bit_cast(h16x2, w).y; }
__device__ __forceinline__ float wave_sum(float v) {
#pragma unroll
    for (int o = 1; o < 64; o <<= 1) v += __shfl_xor(v, o);
    return v;
}
__device__ __forceinline__ float wave_max(float v) {
#pragma unroll
    for (int o = 1; o < 64; o <<= 1) v = fmaxf(v, __shfl_xor(v, o));
    return v;
}
__device__ __forceinline__ float sigmoidf_(float x) { return __builtin_amdgcn_rcpf(1.f + __expf(-x)); }
__device__ __forceinline__ float siluf_(float x) { return x * sigmoidf_(x); }
__device__ __forceinline__ float gelu_tanh(float x) { const float u = x * (1.5957691216057308f + 0.07135481627f * x * x); return x * __builtin_amdgcn_rcpf(1.f + __expf(-u)); }
#define LDS_WAIT() asm volatile("s_waitcnt lgkmcnt(0)" ::: "memory")

__device__ __forceinline__ void sincos_d(double x, double& s, double& c) {
    const double TWO_PI = 6.283185307179586476925286766559;
    const double n = rint(x / TWO_PI);
    const double r = x - n * TWO_PI, r2 = r * r;
    double ts = r, tc = 1.0; s = r; c = 1.0;
#pragma unroll 1
    for (int k = 1; k <= 16; ++k) { tc = -tc * r2 / (double)((2 * k - 1) * (2 * k)); c += tc; ts = -ts * r2 / (double)((2 * k) * (2 * k + 1)); s += ts; }
}

__device__ __forceinline__ void tr_block(const float* W, int ldw, int k0, int c0, bf16* WT, int ldt, int n0, LAS float* scr, int lane, bool fold, const float* gk, const float* bk, float* c1, float* c2, int nvalid) {
#pragma unroll 8
    for (int i = 0; i < 32; ++i) { const int kk = 2 * i + (lane >> 5); scr[kk * 33 + (lane & 31)] = W[(size_t)(k0 + kk) * ldw + c0 + (lane & 31)]; }
    LDS_WAIT(); asm volatile("" ::: "memory");
    const int c = lane & 7;
    if (!fold) {
#pragma unroll
        for (int j = 0; j < 4; ++j) { const int n = (lane >> 3) + 8 * j; const LAS float* s = scr + (8 * c) * 33 + n;
            v4u o; o.x = pkbf(s[0 * 33], s[1 * 33]); o.y = pkbf(s[2 * 33], s[3 * 33]); o.z = pkbf(s[4 * 33], s[5 * 33]); o.w = pkbf(s[6 * 33], s[7 * 33]);
            *(v4u*)(WT + (size_t)(n0 + n) * ldt + k0 + 8 * c) = o; }
    } else {
        float gv[8], bv[8];
#pragma unroll
        for (int i = 0; i < 8; ++i) { gv[i] = gk ? gk[k0 + 8 * c + i] : 1.f; bv[i] = bk ? bk[k0 + 8 * c + i] : 0.f; }
#pragma unroll
        for (int j = 0; j < 4; ++j) { const int n = (lane >> 3) + 8 * j; const LAS float* s = scr + (8 * c) * 33 + n; const float live = n < nvalid ? 1.f : 0.f;
            float w[8]; float p2 = 0.f;
#pragma unroll
            for (int i = 0; i < 8; ++i) { const float raw = s[i * 33] * live; w[i] = raw * gv[i]; p2 += raw * bv[i]; }
            v4u o; o.x = pkh(w[0], w[1]); o.y = pkh(w[2], w[3]); o.z = pkh(w[4], w[5]); o.w = pkh(w[6], w[7]);
            *(v4u*)(WT + (size_t)(n0 + n) * ldt + k0 + 8 * c) = o;
            float p1 = ((hlo(o.x) + hhi(o.x)) + (hlo(o.y) + hhi(o.y))) + ((hlo(o.z) + hhi(o.z)) + (hlo(o.w) + hhi(o.w)));
            p1 += __shfl_xor(p1, 1); p1 += __shfl_xor(p1, 2); p1 += __shfl_xor(p1, 4); p2 += __shfl_xor(p2, 1); p2 += __shfl_xor(p2, 2); p2 += __shfl_xor(p2, 4);
            if (c == 0) { atomicAdd(c1 + n0 + n, p1); atomicAdd(c2 + n0 + n, p2); } }
    }
    LDS_WAIT(); asm volatile("" ::: "memory");
}
__device__ __forceinline__ void tr_job(const float* W, const float* W2, int ldw, int K, int ndest, bf16* WT, int mode, LAS float* scr, int gw, int NGW, int lane,
                                       bool fold = false, const float* gk = nullptr, const float* bk = nullptr, float* c1 = nullptr, float* c2 = nullptr) {
    const int nb = ndest / 32, items = (K / 64) * nb;
    for (int it = gw; it < items; it += NGW) {
        const int kb = it / nb, n0 = (it % nb) * 32; const float* src = W; int c0 = n0, nvalid = 32;
        if (mode == 1) { const int pn = n0 >> 8, bj = (n0 >> 7) & 1, cc = n0 & 127; src = bj ? W2 : W; c0 = 128 * pn + cc; }
        else if (mode == 2) { if (n0 < 1024) { const int pn = n0 >> 8, half = (n0 >> 7) & 1, v = (n0 >> 5) & 3; c0 = 256 * pn + 64 * v + 32 * half; } else if (n0 >= 2816) { c0 = 2560; nvalid = n0 == 2816 ? 8 : 0; } else if (n0 >= 2560) c0 = n0 + 8; }
        tr_block(src, ldw, kb * 64, c0, WT, K, n0, scr, lane, fold, gk, bk, c1, c2, nvalid);
    }
}

__device__ __forceinline__ void layer_prep1(CArgs& A, LAS unsigned char* lds, int l) {
    l = lnd(l);
    const int tid = tidx(), lane = tid & 63, wave = tid >> 6, G = gdim(), bid = bidx();
    const int gw = bid * 8 + wave, NGW = G * 8, gt = bid * 512 + tid, NGT = G * 512;
    LAS float* scr = (LAS float*)(lds + wave * 16384);
    bf16* Wb = (bf16*)(A.ws + WS_W);
    const size_t f1 = (size_t)1024 * 2816;
    float* c1v = (float*)(A.ws + WS_CC) + (size_t)l * CC_L; float* c2v = c1v + CC_N;
    const float* lg = A.in[5] + l * 4096; const float* lb = A.in[6] + l * 4096;
    tr_job(A.in[2] + (size_t)(l * 2 + 0) * f1, A.in[3] + (size_t)(l * 2 + 0) * f1, 2816, 1024, 5632, Wb + WO_GU1, 1, scr, gw, NGW, lane, true, l ? lg - 1024 : nullptr, l ? lb - 1024 : nullptr, c1v + CC_GU1, c2v + CC_GU1);
    tr_job(A.in[2] + (size_t)(l * 2 + 1) * f1, A.in[3] + (size_t)(l * 2 + 1) * f1, 2816, 1024, 5632, Wb + WO_GU2, 1, scr, gw, NGW, lane, true, lg + 2048, lb + 2048, c1v + CC_GU2, c2v + CC_GU2);
    tr_job(A.in[4] + (size_t)(l * 2 + 0) * f1, nullptr, 1024, 2816, 1024, Wb + WO_D1, 0, scr, gw, NGW, lane);
    tr_job(A.in[4] + (size_t)(l * 2 + 1) * f1, nullptr, 1024, 2816, 1024, Wb + WO_D2, 0, scr, gw, NGW, lane);
    tr_job(A.in[7] + (size_t)l * 1024 * DINW, nullptr, DINW, 1024, 3072, Wb + WO_IN, 2, scr, gw, NGW, lane, true, lg, lb, c1v + CC_IN, c2v + CC_IN);
    tr_job(A.in[24] + (size_t)l * 1024 * 1024, nullptr, 1024, 1024, 1024, Wb + WO_OUT, 0, scr, gw, NGW, lane);
    tr_job(A.in[25] + (size_t)l * 1024 * 1024, nullptr, 1024, 1024, 1024, Wb + WO_Q, 0, scr, gw, NGW, lane, true, lg + 1024, lb + 1024, c1v + CC_Q, c2v + CC_Q);
    tr_job(A.in[26] + (size_t)l * 1024 * 2048, nullptr, 2048, 1024, 2048, Wb + WO_KV, 0, scr, gw, NGW, lane);
    tr_job(A.in[27] + (size_t)l * 1024 * 1024, nullptr, 1024, 1024, 1024, Wb + WO_O, 0, scr, gw, NGW, lane);
    tr_job(A.in[22] + (size_t)l * 256 * 256, nullptr, 256, 256, 256, Wb + WO_GLU, 0, scr, gw, NGW, lane);
}
__device__ __forceinline__ void prep0(CArgs& A) {
    const int tid = tidx(), G = gdim(), bid = bidx(); const int gt = bid * 512 + tid, NGT = G * 512;
    for (int l = 0; l < 2; ++l) {
    { float* POW = (float*)(A.ws + WS_POW) + l * POW_L; float* BBAR = (float*)(A.ws + WS_BBAR) + l * BBAR_L; float* LAML = (float*)(A.ws + WS_LAML) + l * LAML_L;
      const float* are = A.in[14] + l * 1024; const float* aim = A.in[15] + l * 1024; const float* lst = A.in[16] + l * 16;
      const float* bre = A.in[17] + (size_t)l * 16384; const float* bim = A.in[18] + (size_t)l * 16384;
      for (int i = gt; i < 16 * 65 * 64; i += NGT) { const int g = i / (65 * 64), tau = (i >> 6) % 65, p = i & 63;
          const double step = exp((double)lst[g]); const double ar = (double)are[g * 64 + p], ai = (double)aim[g * 64 + p];
          const double mag = exp((double)tau * ar * step); double s, c; sincos_d((double)tau * ai * step, s, c);
          POW[2 * i] = (float)(mag * c); POW[2 * i + 1] = (float)(mag * s);
          if (tau == 64) { LAML[2 * (g * 64 + p)] = (float)(mag * c); LAML[2 * (g * 64 + p) + 1] = (float)(mag * s); } }
      for (int i = gt; i < 16 * 64 * 16; i += NGT) { const int g = i >> 10, p = (i >> 4) & 63;
          const double step = exp((double)lst[g]); const double ar = (double)are[g * 64 + p], ai = (double)aim[g * 64 + p];
          const double mag = exp(ar * step); double s, c; sincos_d(ai * step, s, c);
          const double lr = mag * c - 1.0, li = mag * s, den = ar * ar + ai * ai;
          const double zr = (lr * ar + li * ai) / den, zi = (li * ar - lr * ai) / den;
          const double br = (double)bre[i], bi = (double)bim[i];
          BBAR[2 * i] = (float)(zr * br - zi * bi); BBAR[2 * i + 1] = (float)(zr * bi + zi * br); } }
    }
    {
        float* RC = (float*)(A.ws + WS_ROPE); float* RS = RC + 4096 * 32;
        for (int i = gt; i < 4096 * 32; i += NGT) { const int pos = i >> 5, k = i & 31;
            const float inv = (float)exp(-(double)(2 * k) / 64.0 * 9.210340371976184); const float ang = (float)pos * inv;
            double s, c; sincos_d((double)ang, s, c); RC[i] = (float)c; RS[i] = (float)s; }
        { float* rid = (float*)(A.ws + WS_RSTID); for (int i = gt; i < 2 * MT; i += NGT) rid[i] = (i & 1) ? 1.f : 0.f;
          float* on = (float*)(A.ws + WS_ONES); float* ze = (float*)(A.ws + WS_ZEROS); for (int i = gt; i < 1024; i += NGT) { on[i] = 1.f; ze[i] = 0.f; } }
        { const f32x4* x4 = (const f32x4*)A.in[0]; v2u* oh = (v2u*)(A.ws + WS_Y);
          for (size_t i = gt; i < (size_t)MT * DM / 4; i += NGT) { const f32x4 v = x4[i]; v2u h; h.x = pkh(v.x, v.y); h.y = pkh(v.z, v.w); oh[i] = h; } }
        { const f32x4* x4 = (const f32x4*)A.in[1]; v2u* o = (v2u*)(A.ws + WS_MEMB);
          for (size_t i = gt; i < (size_t)4096 * DM / 4; i += NGT) { const f32x4 v = x4[i]; v2u w; w.x = pkbf(v.x, v.y); w.y = pkbf(v.z, v.w); o[i] = w; } }
    }
}
__device__ __forceinline__ void s5_ktab(CArgs& A, int l) {
    l = lnd(l);
    const int gt = bidx() * 512 + tidx(), NGT = gdim() * 512;
    const float* POW = (const float*)(A.ws + WS_POW) + l * POW_L; const float* BBAR = (const float*)(A.ws + WS_BBAR) + l * BBAR_L; float* KT = (float*)(A.ws + WS_KTAB);
    const float* cre = A.in[19] + (size_t)l * 16384; const float* cim = A.in[20] + (size_t)l * 16384;
    for (int i = gt; i < 16 * 64 * 256; i += NGT) { const int g = i >> 14, tau = (i >> 8) & 63, co = (i >> 4) & 15, ci = i & 15; float acc = 0.f;
        for (int p = 0; p < 64; ++p) { const float cr = cre[(g * 16 + co) * 64 + p], cm = cim[(g * 16 + co) * 64 + p];
            const f32x2 P = *(const f32x2*)(POW + 2 * ((g * 65 + tau) * 64 + p)); const f32x2 B = *(const f32x2*)(BBAR + 2 * ((g * 64 + p) * 16 + ci));
            const float zr = P.x * B.x - P.y * B.y, zi = P.x * B.y + P.y * B.x; acc += cr * zr - cm * zi; }
        KT[i] = acc; }
}
__device__ __forceinline__ void s5_fill(CArgs& A, int l) {
    l = lnd(l);
    const int gt = bidx() * 512 + tidx(), NGT = gdim() * 512;
    const float* POW = (const float*)(A.ws + WS_POW) + l * POW_L; const float* BBAR = (const float*)(A.ws + WS_BBAR) + l * BBAR_L; const float* KT = (const float*)(A.ws + WS_KTAB);
    const float* cre = A.in[19] + (size_t)l * 16384; const float* cim = A.in[20] + (size_t)l * 16384; const float* Dk = A.in[21] + l * 256;
    bf16* TF = (bf16*)(A.ws + WS_TF); bf16* EM = (bf16*)(A.ws + WS_EM);
    for (int i = gt; i < 16384 * 144; i += NGT) { const int row = i / 144, k8 = i % 144, g = row >> 10, t = (row >> 4) & 63, co = row & 15; float v[8];
        if (k8 < 128) { const int s = k8 >> 1, ci0 = (k8 & 1) * 8;
#pragma unroll
            for (int j = 0; j < 8; ++j) { const int ci = ci0 + j; float x = 0.f; if (s <= t) { x = KT[((g * 64 + (t - s)) * 16 + co) * 16 + ci]; if (s == t && ci == co) x += Dk[g * 16 + co]; } v[j] = x; } }
        else {
#pragma unroll
            for (int j = 0; j < 8; ++j) { const int q = (k8 - 128) * 8 + j, p = q >> 1, ri = q & 1; const float cr = cre[(g * 16 + co) * 64 + p], cm = cim[(g * 16 + co) * 64 + p];
                const f32x2 P = *(const f32x2*)(POW + 2 * ((g * 65 + t + 1) * 64 + p)); v[j] = ri ? -(cr * P.y + cm * P.x) : (cr * P.x - cm * P.y); } }
        v4u o; o.x = pkbf(v[0], v[1]); o.y = pkbf(v[2], v[3]); o.z = pkbf(v[4], v[5]); o.w = pkbf(v[6], v[7]);
        *(v4u*)(TF + (size_t)row * 1152 + k8 * 8) = o; }
    for (int i = gt; i < 4096 * 128; i += NGT) { const int row = i >> 7, k8 = i & 127, g = row >> 8, n_ = row & 255, s = k8 >> 1, ci0 = (k8 & 1) * 8; float v[8];
#pragma unroll
        for (int j = 0; j < 8; ++j) { float x = 0.f; if (n_ < 128) { const int p = n_ >> 1, ri = n_ & 1; const f32x2 P = *(const f32x2*)(POW + 2 * ((g * 65 + (63 - s)) * 64 + p));
                const f32x2 B = *(const f32x2*)(BBAR + 2 * ((g * 64 + p) * 16 + ci0 + j)); x = ri ? (P.x * B.y + P.y * B.x) : (P.x * B.x - P.y * B.y); } v[j] = x; }
        v4u o; o.x = pkbf(v[0], v[1]); o.y = pkbf(v[2], v[3]); o.z = pkbf(v[4], v[5]); o.w = pkbf(v[6], v[7]);
        *(v4u*)(EM + (size_t)row * 1024 + k8 * 8) = o; }
}

__device__ __forceinline__ void ln_phase(const bf16* YB, const float* gam, const float* bet, float* X, bf16* XB, const float* WG, float* GATES, float* RST) {
    const int tid = tidx(), lane = tid & 63, wave = tid >> 6; const int gw = bidx() * 8 + wave, NGW = gdim() * 8;
    f32x4 gg[2][2], bb[2][2];
#pragma unroll
    for (int j = 0; j < 2; ++j)
#pragma unroll
        for (int q = 0; q < 2; ++q) { gg[j][q] = *(const f32x4*)(gam + lane * 8 + 512 * j + 4 * q); bb[j][q] = *(const f32x4*)(bet + lane * 8 + 512 * j + 4 * q); }
    for (int row0 = gw * 4; row0 < MT; row0 += NGW * 4) {
        v4u raw[4][2];
#pragma unroll
        for (int r = 0; r < 4; ++r)
#pragma unroll
            for (int j = 0; j < 2; ++j) raw[r][j] = *(const v4u*)(YB + (size_t)(row0 + r) * DM + lane * 8 + 512 * j);
        __builtin_amdgcn_sched_barrier(0);
#pragma unroll
        for (int r = 0; r < 4; ++r) { const int row = row0 + r; f32x4 v[2][2]; float s = 0.f;
#pragma unroll
            for (int j = 0; j < 2; ++j) { v[j][0] = (f32x4){hlo(raw[r][j].x), hhi(raw[r][j].x), hlo(raw[r][j].y), hhi(raw[r][j].y)}; v[j][1] = (f32x4){hlo(raw[r][j].z), hhi(raw[r][j].z), hlo(raw[r][j].w), hhi(raw[r][j].w)};
                s += ((v[j][0].x + v[j][0].y) + (v[j][0].z + v[j][0].w)) + ((v[j][1].x + v[j][1].y) + (v[j][1].z + v[j][1].w)); }
            const float mean = wave_sum(s) * (1.f / DM); float s2 = 0.f;
#pragma unroll
            for (int j = 0; j < 2; ++j)
#pragma unroll
                for (int q = 0; q < 2; ++q) { v[j][q] = v[j][q] - mean; s2 += (v[j][q].x * v[j][q].x + v[j][q].y * v[j][q].y) + (v[j][q].z * v[j][q].z + v[j][q].w * v[j][q].w); }
            const float rstd = 1.f / sqrtf(wave_sum(s2) * (1.f / DM) + EPS);
            if (lane == 0) *(f32x2*)(RST + 2 * (size_t)row) = (f32x2){mean, rstd};
#pragma unroll
            for (int j = 0; j < 2; ++j) { v[j][0] = v[j][0] * rstd * gg[j][0] + bb[j][0]; v[j][1] = v[j][1] * rstd * gg[j][1] + bb[j][1];
                v4u w; w.x = pkbf(v[j][0].x, v[j][0].y); w.y = pkbf(v[j][0].z, v[j][0].w); w.z = pkbf(v[j][1].x, v[j][1].y); w.w = pkbf(v[j][1].z, v[j][1].w);
                if (XB) *(v4u*)(XB + (size_t)row * DM + lane * 8 + 512 * j) = w; }
            if (X) {
#pragma unroll
                for (int j = 0; j < 2; ++j) { *(f32x4*)(X + (size_t)row * DM + lane * 8 + 512 * j) = v[j][0]; *(f32x4*)(X + (size_t)row * DM + lane * 8 + 512 * j + 4) = v[j][1]; } }
            if (WG) { float mine = 0.f;
#pragma unroll
                for (int gc = 0; gc < 8; ++gc) { float p = 0.f;
#pragma unroll
                    for (int j = 0; j < 2; ++j)
#pragma unroll
                        for (int q = 0; q < 2; ++q) { const f32x4 w = *(const f32x4*)(WG + gc * 1024 + lane * 8 + 512 * j + 4 * q); p += (v[j][q].x * w.x + v[j][q].y * w.y) + (v[j][q].z * w.z + v[j][q].w * w.w); }
                    p = wave_sum(p); if (lane == gc) mine = p; }
                if (lane < 8) GATES[(size_t)row * 8 + lane] = mine; }
        }
    }
}

__device__ __forceinline__ void stat_finalize(const float* SP, float* RST) {
    const int gt = bidx() * 512 + tidx(), NGT = gdim() * 512;
    for (int row = gt; row < MT; row += NGT) { const f32x4* p = (const f32x4*)(SP + (size_t)row * 32); float sm = 0.f, sq = 0.f;
#pragma unroll
        for (int i = 0; i < 8; ++i) { const f32x4 v = p[i]; sm += v.x + v.z; sq += v.y + v.w; }
        const float mean = sm * (1.f / DM), var = fmaxf(sq * (1.f / DM) - mean * mean, 0.f); *(f32x2*)(RST + 2 * (size_t)row) = (f32x2){mean, 1.f / sqrtf(var + EPS)}; }
}

#define EPI_ARGS const f32x4 (&acc)[2][2][4][2], const Unit& u, int wr, int wc, int fr, int fq
#define EPI_IDS() do { const int t_ = tidx(); fr = t_ & 15; fq = (t_ >> 4) & 3; wc = (t_ >> 6) & 3; wr = t_ >> 8; } while (0)
struct LnFold { const float* rst; const float* c1; const float* c2;
    __device__ __forceinline__ f32x4 fix(const f32x4& a, const f32x2& ms, int nrow) const { const f32x4 u = *(const f32x4*)(c1 + nrow), v = *(const f32x4*)(c2 + nrow); return (a - u * ms.x) * ms.y + v; }
    __device__ __forceinline__ void load(int nbase, int row0, f32x4 (&u1)[2][2], f32x4 (&u2)[2][2], f32x2 (&ms)[2][4]) const {
#pragma unroll
        for (int bj = 0; bj < 2; ++bj)
#pragma unroll
            for (int n = 0; n < 2; ++n) { u1[bj][n] = *(const f32x4*)(c1 + nbase + bj * 128 + n * 16); u2[bj][n] = *(const f32x4*)(c2 + nbase + bj * 128 + n * 16); }
#pragma unroll
        for (int ai = 0; ai < 2; ++ai)
#pragma unroll
            for (int m = 0; m < 4; ++m) ms[ai][m] = *(const f32x2*)(rst + 2 * (size_t)(row0 + ai * 128 + m * 16));
    }
    static __device__ __forceinline__ f32x4 app(const f32x4& a, const f32x4& u, const f32x4& v, const f32x2& ms) { return (a - u * ms.x) * ms.y + v; }
};
struct EpiSwiGLU { static constexpr bool PERM = true, AFTER_DRAIN = false; bf16* H; LnFold F;
    __device__ __forceinline__ void operator()(EPI_ARGS) const { EPI_IDS();
        const int row0 = u.pm * 256 + wr * 64 + fr, col0 = u.pn * 128 + wc * 32 + 8 * fq, nb = u.pn * 256 + wc * 32 + 8 * fq;
        f32x4 u1[2][2], u2[2][2]; f32x2 msa[2][4];
#pragma unroll
        for (int bj = 0; bj < 2; ++bj)
#pragma unroll
            for (int n = 0; n < 2; ++n) { u1[bj][n] = *(const f32x4*)(F.c1 + nb + bj * 128 + n * 4); u2[bj][n] = *(const f32x4*)(F.c2 + nb + bj * 128 + n * 4); }
#pragma unroll
        for (int ai = 0; ai < 2; ++ai)
#pragma unroll
            for (int m = 0; m < 4; ++m) msa[ai][m] = *(const f32x2*)(F.rst + 2 * (size_t)(row0 + ai * 128 + m * 16));
#pragma unroll
        for (int ai = 0; ai < 2; ++ai)
#pragma unroll
            for (int m = 0; m < 4; ++m) { const int r = row0 + ai * 128 + m * 16; const f32x2 ms = msa[ai][m]; v4u w;
                { const f32x4 g = LnFold::app(acc[ai][0][m][0], u1[0][0], u2[0][0], ms), up = LnFold::app(acc[ai][1][m][0], u1[1][0], u2[1][0], ms);
                  w.x = pkbf(siluf_(g[0]) * up[0], siluf_(g[1]) * up[1]); w.y = pkbf(siluf_(g[2]) * up[2], siluf_(g[3]) * up[3]); }
                { const f32x4 g = LnFold::app(acc[ai][0][m][1], u1[0][1], u2[0][1], ms), up = LnFold::app(acc[ai][1][m][1], u1[1][1], u2[1][1], ms);
                  w.z = pkbf(siluf_(g[0]) * up[0], siluf_(g[1]) * up[1]); w.w = pkbf(siluf_(g[2]) * up[2], siluf_(g[3]) * up[3]); }
                *(v4u*)(H + (size_t)r * DFF + col0) = w; }
    }
};
struct EpiResid { static constexpr bool PERM = false, AFTER_DRAIN = false; const bf16* Xr; bf16* Y; float s; const float* rst; const float* gam; const float* bet; float* sp;
    __device__ __forceinline__ void operator()(EPI_ARGS) const { EPI_IDS();
        const int row0 = u.pm * 256 + wr * 64 + fr, col0 = u.pn * 256 + wc * 32 + 4 * fq;
        f32x4 gg[2][2], bb[2][2];
#pragma unroll
        for (int bj = 0; bj < 2; ++bj)
#pragma unroll
            for (int n = 0; n < 2; ++n) { gg[bj][n] = *(const f32x4*)(gam + col0 + bj * 128 + n * 16) * ALPHA; bb[bj][n] = *(const f32x4*)(bet + col0 + bj * 128 + n * 16) * ALPHA; }
#pragma unroll
        for (int ai = 0; ai < 2; ++ai) {
            v2u x[4][2][2]; f32x2 ms[4];
#pragma unroll
            for (int m = 0; m < 4; ++m) { const int r = row0 + ai * 128 + m * 16; const size_t off = (size_t)r * DM + col0; ms[m] = *(const f32x2*)(rst + 2 * (size_t)r);
#pragma unroll
                for (int bj = 0; bj < 2; ++bj)
#pragma unroll
                    for (int n = 0; n < 2; ++n) x[m][bj][n] = *(const v2u*)(Xr + off + bj * 128 + n * 16); }
            __builtin_amdgcn_sched_barrier(0);
#pragma unroll
            for (int m = 0; m < 4; ++m) { const int r = row0 + ai * 128 + m * 16; const size_t off = (size_t)r * DM + col0; float sm = 0.f, sq = 0.f;
#pragma unroll
                for (int bj = 0; bj < 2; ++bj)
#pragma unroll
                    for (int n = 0; n < 2; ++n) { const f32x4 xv = (f32x4){hlo(x[m][bj][n].x), hhi(x[m][bj][n].x), hlo(x[m][bj][n].y), hhi(x[m][bj][n].y)};
                        const f32x4 y = ((xv - ms[m].x) * ms[m].y) * gg[bj][n] + bb[bj][n] + acc[ai][bj][m][n] * s; v2u w; w.x = pkh(y[0], y[1]); w.y = pkh(y[2], y[3]);
                        *(v2u*)(Y + off + bj * 128 + n * 16) = w;
                        const float y0 = hlo(w.x), y1 = hhi(w.x), y2 = hlo(w.y), y3 = hhi(w.y); sm += (y0 + y1) + (y2 + y3); sq += (y0 * y0 + y1 * y1) + (y2 * y2 + y3 * y3); }
                sm += __shfl_xor(sm, 16); sm += __shfl_xor(sm, 32); sq += __shfl_xor(sq, 16); sq += __shfl_xor(sq, 32);
                if (fq == 0) *(f32x2*)(sp + ((size_t)r * 16 + u.pn * 4 + wc) * 2) = (f32x2){sm, sq}; }
            __builtin_amdgcn_sched_barrier(0);
        }
    }
};
struct EpiBf16 { static constexpr bool PERM = false, AFTER_DRAIN = false; static constexpr int ld = DM; static constexpr float s = 0.0625f * LOG2E; bf16* O; LnFold F;
    __device__ __forceinline__ void operator()(EPI_ARGS) const { EPI_IDS();
        const int row0 = u.pm * 256 + wr * 64 + fr, col0 = u.pn * 256 + wc * 32 + 4 * fq;
        f32x4 u1[2][2], u2[2][2]; f32x2 msa[2][4]; F.load(col0, row0, u1, u2, msa);
#pragma unroll
        for (int ai = 0; ai < 2; ++ai)
#pragma unroll
            for (int m = 0; m < 4; ++m) { const int r = row0 + ai * 128 + m * 16; bf16* rp = O + (size_t)r * ld + col0; const f32x2 ms = msa[ai][m];
#pragma unroll
                for (int bj = 0; bj < 2; ++bj)
#pragma unroll
                    for (int n = 0; n < 2; ++n) { const f32x4 v = LnFold::app(acc[ai][bj][m][n], u1[bj][n], u2[bj][n], ms) * s; v2u w; w.x = pkbf(v[0], v[1]); w.y = pkbf(v[2], v[3]); *(v2u*)(rp + bj * 128 + n * 16) = w; } }
    }
};
struct EpiProj { static constexpr bool PERM = false, AFTER_DRAIN = false; bf16* P; bf16* VT; bf16* SUX; const float* RC; const float* RS; LnFold F; float* GATES;
    __device__ __forceinline__ void operator()(EPI_ARGS) const { EPI_IDS();
        const int row0 = u.pm * 256 + wr * 64 + fr; const int pn = u.pn;
        f32x4 u1[2][2], u2[2][2]; f32x2 msa[2][4]; F.load(pn * 256 + wc * 32 + 4 * fq, row0, u1, u2, msa);
        if (pn < 4) { const float sc = pn < 2 ? 0.125f * LOG2E : 1.f;
#pragma unroll
            for (int ai = 0; ai < 2; ++ai)
#pragma unroll
                for (int m = 0; m < 4; ++m) { const int r = row0 + ai * 128 + m * 16, pos = r & 4095; bf16* rp = P + (size_t)r * NPJ + pn * 256 + wc * 64 + 4 * fq; const f32x2 ms = msa[ai][m];
#pragma unroll
                    for (int n = 0; n < 2; ++n) { const f32x4 c = *(const f32x4*)(RC + pos * 32 + n * 16 + 4 * fq), s = *(const f32x4*)(RS + pos * 32 + n * 16 + 4 * fq);
                        const f32x4 t1 = LnFold::app(acc[ai][0][m][n], u1[0][n], u2[0][n], ms), t2 = LnFold::app(acc[ai][1][m][n], u1[1][n], u2[1][n], ms); const f32x4 o1 = (t1 * c - t2 * s) * sc, o2 = (t2 * c + t1 * s) * sc; v2u w;
                        w.x = pkbf(o1[0], o1[1]); w.y = pkbf(o1[2], o1[3]); *(v2u*)(rp + n * 16) = w; w.x = pkbf(o2[0], o2[1]); w.y = pkbf(o2[2], o2[3]); *(v2u*)(rp + 32 + n * 16) = w; } }
        } else if (pn < 6) {
#pragma unroll
            for (int ai = 0; ai < 2; ++ai)
#pragma unroll
                for (int m = 0; m < 4; ++m) { const int r = row0 + ai * 128 + m * 16, b = r >> 12, sp = r & 4095; const f32x2 ms = msa[ai][m];
#pragma unroll
                    for (int bj = 0; bj < 2; ++bj) { const int h = 2 * (pn - 4) + bj; bf16* vp = VT + ((size_t)((b * 4 + h) * 128 + wc * 32 + 4 * fq)) * 4096 + sp;
#pragma unroll
                        for (int n = 0; n < 2; ++n) { const f32x4 v = LnFold::app(acc[ai][bj][m][n], u1[bj][n], u2[bj][n], ms); const unsigned w0 = pkbf(v[0], v[1]), w1 = pkbf(v[2], v[3]);
                            vp[(size_t)(n * 16 + 0) * 4096] = (bf16)(w0 & 0xffff); vp[(size_t)(n * 16 + 1) * 4096] = (bf16)(w0 >> 16);
                            vp[(size_t)(n * 16 + 2) * 4096] = (bf16)(w1 & 0xffff); vp[(size_t)(n * 16 + 3) * 4096] = (bf16)(w1 >> 16); } } }
        } else if (pn < 10) {
#pragma unroll
            for (int ai = 0; ai < 2; ++ai)
#pragma unroll
                for (int m = 0; m < 4; ++m) { const int r = row0 + ai * 128 + m * 16; bf16* rp = P + (size_t)r * NPJ + pn * 256 + wc * 32 + 4 * fq; const f32x2 ms = msa[ai][m];
#pragma unroll
                    for (int bj = 0; bj < 2; ++bj)
#pragma unroll
                        for (int n = 0; n < 2; ++n) { const f32x4 v = LnFold::app(acc[ai][bj][m][n], u1[bj][n], u2[bj][n], ms); v2u w; w.x = pkbf(v[0], v[1]); w.y = pkbf(v[2], v[3]); *(v2u*)(rp + bj * 128 + n * 16) = w; } }
        } else if (pn == 11) {
            if (wc == 0 && fq < 2) {
#pragma unroll
                for (int ai = 0; ai < 2; ++ai)
#pragma unroll
                    for (int m = 0; m < 4; ++m) { const int r = row0 + ai * 128 + m * 16; const f32x2 ms = msa[ai][m];
                        *(f32x4*)(GATES + (size_t)r * 8 + 4 * fq) = LnFold::app(acc[ai][0][m][0], u1[0][0], u2[0][0], ms); } }
        } else {
#pragma unroll
            for (int ai = 0; ai < 2; ++ai)
#pragma unroll
                for (int m = 0; m < 4; ++m) { const int r = row0 + ai * 128 + m * 16, mch = r >> 6, t = r & 63; const f32x2 ms = msa[ai][m];
#pragma unroll
                    for (int bj = 0; bj < 2; ++bj)
#pragma unroll
                        for (int n = 0; n < 2; ++n) { const int g = 8 * bj + 2 * wc + n; const f32x4 v = LnFold::app(acc[ai][bj][m][n], u1[bj][n], u2[bj][n], ms); v2u w; w.x = pkbf(v[0], v[1]); w.y = pkbf(v[2], v[3]);
                            *(v2u*)(SUX + ((size_t)g * 1024 + mch) * 1152 + t * 16 + 4 * fq) = w; } }
        }
    }
};
struct EpiKV { static constexpr bool PERM = false, AFTER_DRAIN = false; bf16* KX; bf16* VTX;
    __device__ __forceinline__ void operator()(EPI_ARGS) const { EPI_IDS();
        const int row0 = u.pm * 256 + wr * 64 + fr; const int pn = u.pn;
        if (pn < 4) {
#pragma unroll
            for (int ai = 0; ai < 2; ++ai)
#pragma unroll
                for (int m = 0; m < 4; ++m) { bf16* rp = KX + (size_t)(row0 + ai * 128 + m * 16) * 1024 + pn * 256 + wc * 32 + 4 * fq;
#pragma unroll
                    for (int bj = 0; bj < 2; ++bj)
#pragma unroll
                        for (int n = 0; n < 2; ++n) { const f32x4 v = acc[ai][bj][m][n]; v2u w; w.x = pkbf(v[0], v[1]); w.y = pkbf(v[2], v[3]); *(v2u*)(rp + bj * 128 + n * 16) = w; } }
        } else { const int h = pn - 4;
#pragma unroll
            for (int ai = 0; ai < 2; ++ai)
#pragma unroll
                for (int m = 0; m < 4; ++m) { const int r = row0 + ai * 128 + m * 16, b = r >> 8, sp = r & 255;
#pragma unroll
                    for (int bj = 0; bj < 2; ++bj) { bf16* vp = VTX + ((size_t)((b * 4 + h) * 256 + bj * 128 + wc * 32 + 4 * fq)) * 256 + sp;
#pragma unroll
                        for (int n = 0; n < 2; ++n) { const f32x4 v = acc[ai][bj][m][n]; const unsigned w0 = pkbf(v[0], v[1]), w1 = pkbf(v[2], v[3]);
                            vp[(n * 16 + 0) * 256] = (bf16)(w0 & 0xffff); vp[(n * 16 + 1) * 256] = (bf16)(w0 >> 16);
                            vp[(n * 16 + 2) * 256] = (bf16)(w1 & 0xffff); vp[(n * 16 + 3) * 256] = (bf16)(w1 >> 16); } } }
        }
    }
};
struct EpiS5E { static constexpr bool PERM = false, AFTER_DRAIN = false; float* E;
    __device__ __forceinline__ void operator()(EPI_ARGS) const { EPI_IDS();
        const int row0 = u.pm * 256 + wr * 64 + fr;
#pragma unroll
        for (int ai = 0; ai < 2; ++ai)
#pragma unroll
            for (int m = 0; m < 4; ++m) { float* rp = E + (size_t)(row0 + ai * 128 + m * 16) * 128 + wc * 32 + 4 * fq;
#pragma unroll
                for (int n = 0; n < 2; ++n) *(f32x4*)(rp + n * 16) = acc[ai][0][m][n]; }
    }
};
struct EpiS5Y { static constexpr bool PERM = false, AFTER_DRAIN = false; bf16* Yo;
    __device__ __forceinline__ void operator()(EPI_ARGS) const { EPI_IDS();
        const int row0 = u.pm * 256 + wr * 64 + fr; const int pnl = u.pn & 3;
#pragma unroll
        for (int ai = 0; ai < 2; ++ai)
#pragma unroll
            for (int m = 0; m < 4; ++m) { const int R = row0 + ai * 128 + m * 16, g = R >> 10, mch = R & 1023;
#pragma unroll
                for (int bj = 0; bj < 2; ++bj)
#pragma unroll
                    for (int n = 0; n < 2; ++n) { const int t = pnl * 16 + bj * 8 + wc * 2 + n; const f32x4 v = acc[ai][bj][m][n]; v2u w;
                        w.x = pkbf(gelu_tanh(v[0]), gelu_tanh(v[1])); w.y = pkbf(gelu_tanh(v[2]), gelu_tanh(v[3]));
                        *(v2u*)(Yo + ((size_t)mch * 64 + t) * 256 + g * 16 + 4 * fq) = w; asm volatile("" ::: "memory"); } }
    }
};
struct EpiGLU { static constexpr bool PERM = false, AFTER_DRAIN = false; const bf16* Ys; const float* gb; bf16* CAT;
    __device__ __forceinline__ void operator()(EPI_ARGS) const { EPI_IDS();
        const int row0 = u.pm * 256 + wr * 64 + fr, col0 = wc * 32 + 4 * fq;
#pragma unroll
        for (int ai = 0; ai < 2; ++ai)
#pragma unroll
            for (int m = 0; m < 4; ++m) { const size_t r = (size_t)(row0 + ai * 128 + m * 16);
#pragma unroll
                for (int bj = 0; bj < 2; ++bj)
#pragma unroll
                    for (int n = 0; n < 2; ++n) { const int c = col0 + bj * 128 + n * 16; const f32x4 b = *(const f32x4*)(gb + c); const v2u yw = *(const v2u*)(Ys + r * 256 + c);
                        const f32x4 v = acc[ai][bj][m][n] + b; v2u w;
                        w.x = pkbf(bflo(yw.x) * sigmoidf_(v[0]), bfhi(yw.x) * sigmoidf_(v[1])); w.y = pkbf(bflo(yw.y) * sigmoidf_(v[2]), bfhi(yw.y) * sigmoidf_(v[3]));
                        *(v2u*)(CAT + r * DM + 768 + c) = w; asm volatile("" ::: "memory"); } }
    }
};
struct GroupOrder { int nwg, G, c, npm, npn;
    __device__ __forceinline__ void init(int ngroups, int npm_, int npn_, int G_, int c_) { npm = npm_; npn = npn_; nwg = ngroups * npm_ * npn_; G = G_; c = c_; }
    __device__ __forceinline__ bool next(int i, Unit& u) const { const int L = i * G + c; if (L >= nwg) return false; const int per = npm * npn, g = L / per, r = L % per; u.pm = g * npm + r % npm; u.pn = g * npn + r / npm; return true; }
    __device__ __forceinline__ void a_ready(const Unit&) const {}
    __device__ __forceinline__ void done(const Unit&) const {}
};
template <class Epi, bool F16 = false> __device__ __forceinline__ void run_gemm(LAS unsigned char* lds, const bf16* Ap, const bf16* Bt, int M, int N, int K, int lda, int ldb, const Epi& E) {
    pg8::Gemm g{Ap, Bt, M, N, K, lda, ldb}; pg8::StaticOrder S; S.init(M, N, gdim(), bidx());
    pg8::gemm_phase<Epi, pg8::StaticOrder, true, true, F16>(lds, g, S, E);
}

__device__ __forceinline__ float qmax4(float m) {
    auto r = __builtin_amdgcn_permlane32_swap(__float_as_uint(m), __float_as_uint(m), false, false); m = fmaxf(__uint_as_float(r[0]), __uint_as_float(r[1]));
    auto q = __builtin_amdgcn_permlane16_swap(__float_as_uint(m), __float_as_uint(m), false, false); return fmaxf(__uint_as_float(q[0]), __uint_as_float(q[1]));
}
template <int NMAP, int DQK, int DV>
__device__ __forceinline__ void attn_qks(LAS unsigned char* cur, int qi, int g, const bf16x8 (&qf)[NMAP][DQK / 32], f32x4 (&O)[NMAP][DV / 16], float (&lsum)[NMAP], float (&mrun)[NMAP], bf16x8 (&pf)[NMAP][2]) {
    constexpr int KPL = NMAP * 64 * 16, VPL = DV * 16, VS_OFF = NMAP * 64 * DQK * 2, NKS = DQK / 32;
    float al[NMAP]; bool resc = false;
#pragma unroll
    for (int mp = 0; mp < NMAP; ++mp) {
        f32x4 s[4];
        {
            bf16x8 kf[2][NKS];
#pragma unroll
            for (int ks = 0; ks < NKS; ++ks) kf[0][ks] = *(const LAS bf16x8*)(cur + (ks * 4 + g) * KPL + (mp * 64 + qi) * 16);
#pragma unroll
            for (int jb = 0; jb < 4; ++jb) { s[jb] = (f32x4){0.f, 0.f, 0.f, 0.f};
                if (jb < 3) {
#pragma unroll
                    for (int ks = 0; ks < NKS; ++ks) kf[(jb + 1) & 1][ks] = *(const LAS bf16x8*)(cur + (ks * 4 + g) * KPL + (mp * 64 + 16 * (jb + 1) + qi) * 16); }
                __builtin_amdgcn_sched_barrier(0);
#pragma unroll
                for (int ks = 0; ks < NKS; ++ks) s[jb] = __builtin_amdgcn_mfma_f32_16x16x32_bf16(kf[jb & 1][ks], qf[mp][ks], s[jb], 0, 0, 0);
                __builtin_amdgcn_sched_barrier(0); }
        }
        float mx = fmaxf(fmaxf(fmaxf(s[0][0], s[0][1]), fmaxf(s[0][2], s[0][3])), fmaxf(fmaxf(s[1][0], s[1][1]), fmaxf(s[1][2], s[1][3])));
        mx = fmaxf(mx, fmaxf(fmaxf(fmaxf(s[2][0], s[2][1]), fmaxf(s[2][2], s[2][3])), fmaxf(fmaxf(s[3][0], s[3][1]), fmaxf(s[3][2], s[3][3]))));
        mx = qmax4(mx);
        const bool upd = (mx - mrun[mp]) > 8.f; const float mnew = upd ? mx : mrun[mp]; al[mp] = upd ? __builtin_amdgcn_exp2f(mrun[mp] - mnew) : 1.f; resc = resc || upd; mrun[mp] = mnew;
        float ps = 0.f;
#pragma unroll
        for (int jb = 0; jb < 4; ++jb)
#pragma unroll
            for (int r = 0; r < 4; ++r) { s[jb][r] = __builtin_amdgcn_exp2f(s[jb][r] - mnew); ps += s[jb][r]; }
        lsum[mp] = lsum[mp] * al[mp] + ps;
#pragma unroll
        for (int tg = 0; tg < 2; ++tg) { v4u pw; pw.x = pkbf(s[2 * tg][0], s[2 * tg][1]); pw.y = pkbf(s[2 * tg][2], s[2 * tg][3]); pw.z = pkbf(s[2 * tg + 1][0], s[2 * tg + 1][1]); pw.w = pkbf(s[2 * tg + 1][2], s[2 * tg + 1][3]);
            pf[mp][tg] = __builtin_bit_cast(bf16x8, pw); }
    }
    if (__any(resc)) {
#pragma unroll
        for (int mp = 0; mp < NMAP; ++mp)
#pragma unroll
            for (int db = 0; db < DV / 16; ++db) O[mp][db] = O[mp][db] * al[mp];
    }
}
template <int NMAP, int DQK, int DV, int VBN_ = 0>
__device__ __forceinline__ void attn_pv(LAS unsigned char* cur, int qi, int g, const bf16x8 (&pf)[NMAP][2], f32x4 (&O)[NMAP][DV / 16]) {
    constexpr int VPL = DV * 16, VS_OFF = NMAP * 64 * DQK * 2;
    {
        constexpr int NDB = DV / 16, VBN = VBN_ ? VBN_ : ((DV > 128) ? 4 : 8), NBT = 2 * NDB / VBN;
        bf16x8 vf[2][VBN];
#pragma unroll
        for (int i = 0; i < VBN; ++i) vf[0][i] = *(const LAS bf16x8*)(cur + VS_OFF + g * VPL + (i * 16 + qi) * 16);
#pragma unroll
        for (int bt = 0; bt < NBT; ++bt) {
            if (bt + 1 < NBT) {
#pragma unroll
                for (int i = 0; i < VBN; ++i) { const int f = (bt + 1) * VBN + i, tg = f / NDB, db = f % NDB; vf[(bt + 1) & 1][i] = *(const LAS bf16x8*)(cur + VS_OFF + (tg * 4 + g) * VPL + (db * 16 + qi) * 16); } }
            __builtin_amdgcn_sched_barrier(0);
#pragma unroll
            for (int i = 0; i < VBN; ++i) { const int f = bt * VBN + i, tg = f / NDB, db = f % NDB;
#pragma unroll
                for (int mp = 0; mp < NMAP; ++mp) O[mp][db] = __builtin_amdgcn_mfma_f32_16x16x32_bf16(vf[bt & 1][i], pf[mp][tg], O[mp][db], 0, 0, 0); }
            __builtin_amdgcn_sched_barrier(0);
        }
    }
}
template <int NMAP, int DQK, int DV>
__device__ __forceinline__ void attn_tile(LAS unsigned char* cur, int qi, int g, const bf16x8 (&qf)[NMAP][DQK / 32], f32x4 (&O)[NMAP][DV / 16], float (&lsum)[NMAP], float (&mrun)[NMAP]) {
    bf16x8 pf[NMAP][2]; attn_qks<NMAP, DQK, DV>(cur, qi, g, qf, O, lsum, mrun, pf); attn_pv<NMAP, DQK, DV>(cur, qi, g, pf, O);
}
template <int NMAP, int DQK, int DV, bool DBUF>
__device__ __forceinline__ void attn_core(LAS unsigned char* lds, const bf16* Q, int qpitch, const bf16* K, int kpitch, const bf16* VT, int vpitch,
                                          int NT, int my_nt, f32x4 (&O)[NMAP][DV / 16], float (&lsum)[NMAP]) {
    constexpr int CPR = DQK / 8, KCH = NMAP * 64 * CPR / 512, VCH = DV * 8 / 512, KPL = NMAP * 64 * 16, VPL = DV * 16, VS_OFF = NMAP * 64 * DQK * 2, NKS = DQK / 32, NRG = NMAP * 8;
    constexpr int BUFB = VS_OFF + DV * 128;
    const int tid = tidx(), lane = tid & 63, qi = lane & 15, g = lane >> 4;
    bf16x8 qf[NMAP][NKS];
#pragma unroll
    for (int mp = 0; mp < NMAP; ++mp)
#pragma unroll
        for (int ks = 0; ks < NKS; ++ks) qf[mp][ks] = *(const bf16x8*)(Q + (size_t)qi * qpitch + mp * DQK + ks * 32 + g * 8);
    float mrun[NMAP];
#pragma unroll
    for (int mp = 0; mp < NMAP; ++mp) { mrun[mp] = -INFINITY; lsum[mp] = 0.f;
#pragma unroll
        for (int db = 0; db < DV / 16; ++db) O[mp][db] = (f32x4){0.f, 0.f, 0.f, 0.f}; }
    v4u kregA[KCH], vregA[VCH], kregB[DBUF ? KCH : 1], vregB[DBUF ? VCH : 1];
#define ATT_LOAD(t, KR, VR) do { _Pragma("unroll") for (int i = 0; i < KCH; ++i) { const int w64 = (tid >> 6) + i * 8, prow = (w64 % NRG) * 8 + (lane & 7), ch = (w64 / NRG) * 8 + (lane >> 3), p6 = prow & 63; \
            const int kv = (p6 & 32) + 8 * ((p6 >> 2) & 3) + 4 * ((p6 >> 4) & 1) + (p6 & 3); \
            KR[i] = *(const v4u*)(K + (size_t)((t) * 64 + kv) * kpitch + (prow >> 6) * DQK + ch * 8); } \
        _Pragma("unroll") for (int i = 0; i < VCH; ++i) { const int w64 = (tid >> 6) + i * 8, d = w64 * 8 + (lane & 7), ch = lane >> 3; \
            VR[i] = *(const v4u*)(VT + (size_t)d * vpitch + (t) * 64 + ch * 8); } } while (0)
#define ATT_STORE(B, KR, VR) do { _Pragma("unroll") for (int i = 0; i < KCH; ++i) { const int w64 = (tid >> 6) + i * 8, prow = (w64 % NRG) * 8 + (lane & 7), ch = (w64 / NRG) * 8 + (lane >> 3); *(LAS v4u*)((B) + ch * KPL + prow * 16) = KR[i]; } \
        _Pragma("unroll") for (int i = 0; i < VCH; ++i) { const int w64 = (tid >> 6) + i * 8, d = w64 * 8 + (lane & 7), ch = lane >> 3; *(LAS v4u*)((B) + VS_OFF + ch * VPL + d * 16) = VR[i]; } } while (0)
    if (DBUF) {
        ATT_LOAD(0, kregA, vregA);
        __syncthreads(); ATT_STORE(lds, kregA, vregA);
        ATT_LOAD(1, kregA, vregA); if (NT > 2) ATT_LOAD(2, kregB, vregB);
        __syncthreads();
        for (int t = 0; t < NT; t += 2) {
            ATT_STORE(lds + BUFB, kregA, vregA); if (t + 3 < NT) ATT_LOAD(t + 3, kregA, vregA);
            if (t < my_nt) attn_tile<NMAP, DQK, DV>(lds, qi, g, qf, O, lsum, mrun);
            __syncthreads();
            if (t + 2 < NT) { ATT_STORE(lds, kregB, vregB); if (t + 4 < NT) ATT_LOAD(t + 4, kregB, vregB); }
            if (t + 1 < my_nt) attn_tile<NMAP, DQK, DV>(lds + BUFB, qi, g, qf, O, lsum, mrun);
            __syncthreads();
        }
    } else {
        ATT_LOAD(0, kregA, vregA);
        for (int t = 0; t < NT; ++t) {
            __syncthreads(); ATT_STORE(lds, kregA, vregA); __syncthreads(); if (t + 1 < NT) ATT_LOAD(t + 1, kregA, vregA);
            if (t < my_nt) attn_tile<NMAP, DQK, DV>(lds, qi, g, qf, O, lsum, mrun);
        }
    }
#undef ATT_LOAD
#undef ATT_STORE
#pragma unroll
    for (int mp = 0; mp < NMAP; ++mp) { lsum[mp] += __shfl_xor(lsum[mp], 16); lsum[mp] += __shfl_xor(lsum[mp], 32); }
}

__device__ __forceinline__ void diff_core_skew(LAS unsigned char* lds, const bf16* Q, int qpitch, const bf16* K, int kpitch, const bf16* VT, int vpitch,
                                               int NT, int my_nt, bool lag, f32x4 (&O)[2][8], float (&lsum)[2]) {
    constexpr int NMAP = 2, DQK = 64, DV = 128, CPR = 8, KCH = 2, VCH = 2, KPL = NMAP * 64 * 16, VPL = DV * 16, VS_OFF = NMAP * 64 * DQK * 2, NRG = NMAP * 8, BUFB = VS_OFF + DV * 128;
    const int tid = tidx(), lane = tid & 63, qi = lane & 15, g = lane >> 4;
    bf16x8 qf[2][2];
#pragma unroll
    for (int mp = 0; mp < 2; ++mp)
#pragma unroll
        for (int ks = 0; ks < 2; ++ks) qf[mp][ks] = *(const bf16x8*)(Q + (size_t)qi * qpitch + mp * DQK + ks * 32 + g * 8);
    float mrun[2] = {-INFINITY, -INFINITY}; lsum[0] = 0.f; lsum[1] = 0.f;
#pragma unroll
    for (int mp = 0; mp < 2; ++mp)
#pragma unroll
        for (int db = 0; db < 8; ++db) O[mp][db] = (f32x4){0.f, 0.f, 0.f, 0.f};
    v4u kregA[KCH], vregA[VCH], kregB[KCH], vregB[VCH];
#define SK_LOAD(t, KR, VR) do { _Pragma("unroll") for (int i = 0; i < KCH; ++i) { const int w64 = (tid >> 6) + i * 8, prow = (w64 % NRG) * 8 + (lane & 7), ch = (w64 / NRG) * 8 + (lane >> 3), p6 = prow & 63; \
            const int kv = (p6 & 32) + 8 * ((p6 >> 2) & 3) + 4 * ((p6 >> 4) & 1) + (p6 & 3); \
            KR[i] = *(const v4u*)(K + (size_t)((t) * 64 + kv) * kpitch + (prow >> 6) * DQK + ch * 8); } \
        _Pragma("unroll") for (int i = 0; i < VCH; ++i) { const int w64 = (tid >> 6) + i * 8, d = w64 * 8 + (lane & 7), ch = lane >> 3; \
            VR[i] = *(const v4u*)(VT + (size_t)d * vpitch + (t) * 64 + ch * 8); } } while (0)
#define SK_STORE(B, KR, VR) do { _Pragma("unroll") for (int i = 0; i < KCH; ++i) { const int w64 = (tid >> 6) + i * 8, prow = (w64 % NRG) * 8 + (lane & 7), ch = (w64 / NRG) * 8 + (lane >> 3); *(LAS v4u*)((B) + ch * KPL + prow * 16) = KR[i]; } \
        _Pragma("unroll") for (int i = 0; i < VCH; ++i) { const int w64 = (tid >> 6) + i * 8, d = w64 * 8 + (lane & 7), ch = lane >> 3; *(LAS v4u*)((B) + VS_OFF + ch * VPL + d * 16) = VR[i]; } } while (0)
    bf16x8 pfp[2][2];
#pragma unroll
    for (int mp = 0; mp < 2; ++mp) { pfp[mp][0] = (bf16x8){0, 0, 0, 0, 0, 0, 0, 0}; pfp[mp][1] = pfp[mp][0]; }
#define SK_STEP(t, ic, ip, in_) do { \
        if (!lag) { if ((t) < my_nt) { attn_qks<2, 64, 128>(lds + (ic) * BUFB, qi, g, qf, O, lsum, mrun, pfp); attn_pv<2, 64, 128, 8>(lds + (ic) * BUFB, qi, g, pfp, O); } } \
        else { if ((t) >= 1 && (t) - 1 < my_nt) attn_pv<2, 64, 128, 8>(lds + (ip) * BUFB, qi, g, pfp, O); \
               if ((t) < my_nt) attn_qks<2, 64, 128>(lds + (ic) * BUFB, qi, g, qf, O, lsum, mrun, pfp); } } while (0)
    SK_LOAD(0, kregA, vregA); SK_LOAD(1, kregB, vregB);
    __syncthreads(); SK_STORE(lds, kregA, vregA);
    if (NT > 2) SK_LOAD(2, kregA, vregA);
    __syncthreads();
    int ic = 0, ip = 2, in_ = 1;
    for (int t = 0; t < NT; t += 2) {
        SK_STORE(lds + in_ * BUFB, kregB, vregB); if (t + 3 < NT) SK_LOAD(t + 3, kregB, vregB);
        SK_STEP(t, ic, ip, in_);
        __syncthreads();
        ip = ic; ic = in_; in_ = in_ == 2 ? 0 : in_ + 1;
        if (t + 2 < NT) { SK_STORE(lds + in_ * BUFB, kregA, vregA); if (t + 4 < NT) SK_LOAD(t + 4, kregA, vregA); }
        SK_STEP(t + 1, ic, ip, in_);
        __syncthreads();
        ip = ic; ic = in_; in_ = in_ == 2 ? 0 : in_ + 1;
    }
    if (lag && NT - 1 < my_nt) attn_pv<2, 64, 128, 8>(lds + ip * BUFB, qi, g, pfp, O);
#undef SK_LOAD
#undef SK_STORE
#undef SK_STEP
    lsum[0] += __shfl_xor(lsum[0], 16); lsum[0] += __shfl_xor(lsum[0], 32); lsum[1] += __shfl_xor(lsum[1], 16); lsum[1] += __shfl_xor(lsum[1], 32);
}
__device__ __forceinline__ void diffattn_phase(CArgs& A, LAS unsigned char* lds, int l) {
    l = lnd(l);
    const int tid = tidx(), lane = tid & 63, wave = tid >> 6, qi = lane & 15, g = lane >> 4;
    const bf16* P = (const bf16*)(A.ws + WS_HP); const bf16* VT = (const bf16*)((unsigned char*)A.out + OUT_VT); bf16* CAT = (bf16*)(A.ws + WS_CAT);
    const float lambda_init = 0.8f - 0.6f * expf(-0.3f * (float)l);
    float lam; { const float* dl = A.in[12] + l * 256; float a = 0.f, b2 = 0.f; for (int i = 0; i < 64; ++i) { a += dl[i] * dl[64 + i]; b2 += dl[128 + i] * dl[192 + i]; } lam = expf(a) - expf(b2) + lambda_init; }
    const float* gn = A.in[13] + l * 128;
    const int nblk = gdim(), bid = bidx(); const bool xcd_ok = (nblk == 256);
    for (int it = 0, pi0 = bid; pi0 < 1024; pi0 += nblk, ++it) {
        int pi = pi0; if (xcd_ok) { const int xcd = bid & 7, j = bid >> 3; pi = ((xcd * 8 + it * 2 + (j >> 4)) << 4) | (j & 15); }
        const int bh = pi >> 4, s = pi & 15, b = bh >> 2, h = bh & 3;
        for (int half = 0; half < 2; ++half) {
            const int qblk = half ? 31 - s : s, NT = 2 * qblk + 2, my_nt = 2 * qblk + (wave >> 2) + 1;
            const size_t row0 = (size_t)b * 4096 + qblk * 128 + wave * 16;
            f32x4 O[2][8]; float ls[2];
            diff_core_skew(lds, P + row0 * NPJ + h * 128, NPJ, P + (size_t)b * 4096 * NPJ + 512 + h * 128, NPJ, VT + (size_t)((b * 4 + h) * 128) * 4096, 4096, NT, my_nt, wave >= 4, O, ls);
            const float i1 = 1.f / ls[0], i2 = lam / ls[1]; float ss = 0.f;
#pragma unroll
            for (int db = 0; db < 8; ++db) { O[0][db] = O[0][db] * i1 - O[1][db] * i2; ss += (O[0][db][0] * O[0][db][0] + O[0][db][1] * O[0][db][1]) + (O[0][db][2] * O[0][db][2] + O[0][db][3] * O[0][db][3]); }
            ss += __shfl_xor(ss, 16); ss += __shfl_xor(ss, 32);
            const float rs = (1.f - lambda_init) / sqrtf(ss * (1.f / 128.f) + EPS);
            bf16* op = CAT + (row0 + qi) * DM + h * 128 + 4 * g;
#pragma unroll
            for (int db = 0; db < 8; ++db) { const f32x4 gg = *(const f32x4*)(gn + db * 16 + 4 * g); const f32x4 v = O[0][db] * rs * gg; v2u w; w.x = pkbf(v[0], v[1]); w.y = pkbf(v[2], v[3]); *(v2u*)(op + db * 16) = w; }
        }
    }
    __syncthreads();
}
__device__ __forceinline__ void xattn_phase(CArgs& A, LAS unsigned char* lds) {
    const int tid = tidx(), lane = tid & 63, wave = tid >> 6, qi = lane & 15, g = lane >> 4;
    const bf16* QX = (const bf16*)(A.ws + WS_HP); bf16* OX = (bf16*)(A.ws + WS_HP + 128 * MiB); const bf16* KX = (const bf16*)(A.ws + WS_KX); const bf16* VTX = (const bf16*)(A.ws + WS_VTX);
    for (int u = bidx(); u < 2048; u += gdim()) {
        const int b = u >> 7, h = (u >> 5) & 3, qblk = u & 31; const size_t row0 = (size_t)b * 4096 + qblk * 128 + wave * 16;
        f32x4 O[1][16]; float ls[1];
        attn_core<1, 256, 256, false>(lds, QX + row0 * DM + h * 256, DM, KX + (size_t)b * 256 * DM + h * 256, DM, VTX + (size_t)((b * 4 + h) * 256) * 256, 256, 4, 4, O, ls);
        const float il = 1.f / ls[0]; bf16* op = OX + (row0 + qi) * DM + h * 256 + 4 * g;
#pragma unroll
        for (int db = 0; db < 16; ++db) { const f32x4 v = O[0][db] * il; v2u w; w.x = pkbf(v[0], v[1]); w.y = pkbf(v[2], v[3]); *(v2u*)(op + db * 16) = w; }
    }
    __syncthreads();
}

__device__ __forceinline__ void conv8(CArgs& A, int l, const bf16* P, int b, int pos, int col, int cch, float (&o)[8]) {
    const float* cw = A.in[8] + l * 2048; const float* cb = A.in[9] + l * 512;
#pragma unroll
    for (int e = 0; e < 8; ++e) o[e] = cb[cch + e];
#pragma unroll
    for (int j = 0; j < 4; ++j) { const int pj = pos - 3 + j; if (pj >= 0) { const v4u x = *(const v4u*)(P + ((size_t)b * 4096 + pj) * NPJ + col); const float* w = cw + j * 512 + cch;
            o[0] += w[0] * bflo(x.x); o[1] += w[1] * bfhi(x.x); o[2] += w[2] * bflo(x.y); o[3] += w[3] * bfhi(x.y); o[4] += w[4] * bflo(x.z); o[5] += w[5] * bfhi(x.z); o[6] += w[6] * bflo(x.w); o[7] += w[7] * bfhi(x.w); } }
#pragma unroll
    for (int e = 0; e < 8; ++e) o[e] = siluf_(o[e]);
}
__device__ __forceinline__ float logsigmoidf_(float x) { return fminf(x, 0.f) - log1pf(__expf(-fabsf(x))); }
constexpr int ML_Q = 0, ML_KT = 4160, ML_V = 8256, ML_P = 12352, ML_CT = 16512, ML_MISC = 20608;
__device__ __forceinline__ void mlstm_local(CArgs& A, LAS unsigned char* lds, int l) {
    l = lnd(l);
    const int tid = tidx(), lane = tid & 63, wave = tid >> 6, half = wave >> 2, hw = wave & 3, ht = tid & 255, qi = lane & 15, g = lane >> 4;
    constexpr int PT = 72, HB = 20480;
    LAS unsigned char* hb = lds + half * HB; LAS float* wt = (LAS float*)(hb + 18432);
    const bf16* P = (const bf16*)(A.ws + WS_HP); const float* GT = (const float*)(A.ws + WS_GATES); const float* gb = A.in[10] + l * 8;
    float* Cb = (float*)((unsigned char*)A.out + OUT_C); float* Nb = (float*)(A.ws + WS_NST); float* AB = (float*)(A.ws + WS_AB);
    const int nblk_ = gdim(), bid_ = bidx(); const bool deal = nblk_ == 256;
    const int np_ = deal ? (bid_ < 64 ? 5 : 9) : (2048 - bid_ + nblk_ - 1) / nblk_, p0_ = deal ? (bid_ < 64 ? bid_ * 5 : 320 + (bid_ - 64) * 9) : bid_, ps_ = deal ? 1 : nblk_;
    for (int ip_ = 0; ip_ < np_; ++ip_) { const int u0 = 2 * (p0_ + ip_ * ps_);
        const int u = u0 + half, bh = u >> 6, c = u & 63, b = bh >> 2, h = bh & 3; const int s = ht >> 2, d16 = (ht & 3) * 16, pos = c * 64 + s;
        const size_t prow = ((size_t)b * 4096 + pos) * NPJ;
        const v4u x0 = *(const v4u*)(P + prow + 2048 + h * 64 + d16), x1 = *(const v4u*)(P + prow + 2048 + h * 64 + d16 + 8);
        { float k0[8], k1[8]; conv8(A, l, P, b, pos, 1792 + h * 64 + d16, 256 + h * 64 + d16, k0); conv8(A, l, P, b, pos, 1792 + h * 64 + d16 + 8, 256 + h * 64 + d16 + 8, k1);
          LAS bf16* kt = (LAS bf16*)(hb + 9216) + d16 * PT + s;
#pragma unroll
          for (int e = 0; e < 8; e += 2) { const unsigned w0 = pkbf(k0[e] * 0.125f, k0[e + 1] * 0.125f), w1 = pkbf(k1[e] * 0.125f, k1[e + 1] * 0.125f);
              kt[e * PT] = (bf16)(w0 & 0xffff); kt[(e + 1) * PT] = (bf16)(w0 >> 16); kt[(8 + e) * PT] = (bf16)(w1 & 0xffff); kt[(9 + e) * PT] = (bf16)(w1 >> 16); } }
        if (hw == 0) { const size_t row = (size_t)b * 4096 + c * 64 + lane; const float ig = GT[row * 8 + h] + gb[h]; float bc = logsigmoidf_(GT[row * 8 + 4 + h] + gb[4 + h]);
#pragma unroll
            for (int o = 1; o < 64; o <<= 1) { const float nb = __shfl_up(bc, o); if (lane >= o) bc += nb; }
            const float bl = __shfl(bc, 63), val = bl - bc + ig, a = wave_max(val); wt[lane] = __expf(val - a);
            if (lane == 0) { AB[2 * u] = a; AB[2 * u + 1] = bl; } }
        __syncthreads();
        { const float w = wt[s]; LAS bf16* vt = (LAS bf16*)hb + d16 * PT + s;
          const unsigned xs[8] = {x0.x, x0.y, x0.z, x0.w, x1.x, x1.y, x1.z, x1.w};
#pragma unroll
          for (int e = 0; e < 8; ++e) { const unsigned p = pkbf(bflo(xs[e]) * w, bfhi(xs[e]) * w); vt[(2 * e) * PT] = (bf16)(p & 0xffff); vt[(2 * e + 1) * PT] = (bf16)(p >> 16); } }
        __syncthreads();
        {
            bf16x8 af[2];
#pragma unroll
            for (int ks = 0; ks < 2; ++ks) af[ks] = *(const LAS bf16x8*)(hb + ((hw * 16 + qi) * PT + ks * 32 + g * 8) * 2);
            float* cp = Cb + (size_t)u * 4096 + (hw * 16 + 4 * g) * 64 + qi;
#pragma unroll
            for (int kb = 0; kb < 4; ++kb) { f32x4 acc = (f32x4){0.f, 0.f, 0.f, 0.f};
#pragma unroll
                for (int ks = 0; ks < 2; ++ks) { const bf16x8 bfr = *(const LAS bf16x8*)(hb + 9216 + ((kb * 16 + qi) * PT + ks * 32 + g * 8) * 2); acc = __builtin_amdgcn_mfma_f32_16x16x32_bf16(af[ks], bfr, acc, 0, 0, 0); }
                cp[0 * 64 + kb * 16] = acc[0]; cp[1 * 64 + kb * 16] = acc[1]; cp[2 * 64 + kb * 16] = acc[2]; cp[3 * 64 + kb * 16] = acc[3]; }
            if (ht < 64) { float n = 0.f; const LAS bf16* kr = (const LAS bf16*)(hb + 9216) + ht * PT;
#pragma unroll 8
                for (int ss = 0; ss < 64; ++ss) n += wt[ss] * bf2f(kr[ss]);
                Nb[(size_t)u * 64 + ht] = n; }
        }
        __syncthreads();
    }
}
__device__ __forceinline__ void mlstm_scan(CArgs& A) {
    const int gt = bidx() * 512 + tidx(), NGT = gdim() * 512;
    float* Cb = (float*)((unsigned char*)A.out + OUT_C); float* Nb = (float*)(A.ws + WS_NST); const float* AB = (const float*)(A.ws + WS_AB); float* MS = (float*)(A.ws + WS_MS);
    for (int idx = gt; idx < 64 * 4160; idx += NGT) { const int bh = idx / 4160, e = idx % 4160; float st = 0.f, m = 0.f;
        float* base = e < 4096 ? Cb + (size_t)bh * 64 * 4096 + e : Nb + (size_t)bh * 64 * 64 + (e - 4096); const size_t stride = e < 4096 ? 4096 : 64;
        for (int c0 = 0; c0 < 64; c0 += 8) { float d[8], a[8], bl[8];
#pragma unroll
            for (int j = 0; j < 8; ++j) { d[j] = base[(size_t)(c0 + j) * stride]; a[j] = AB[2 * (bh * 64 + c0 + j)]; bl[j] = AB[2 * (bh * 64 + c0 + j) + 1]; }
#pragma unroll
            for (int j = 0; j < 8; ++j) { base[(size_t)(c0 + j) * stride] = st; if (e == 0) MS[bh * 64 + c0 + j] = m;
                const float mn = fmaxf(bl[j] + m, a[j]); st = __expf(bl[j] + m - mn) * st + __expf(a[j] - mn) * d[j]; m = mn; } } }
}
__device__ __forceinline__ void mlstm_out(CArgs& A, LAS unsigned char* lds, int l) {
    l = lnd(l);
    const int tid = tidx(), lane = tid & 63, wave = tid >> 6, half = wave >> 2, hw = wave & 3, ht = tid & 255, qi = lane & 15, g = lane >> 4;
    constexpr int PT = 72, HB = 40960;
    LAS unsigned char* hb = lds + half * HB; LAS float* tb = (LAS float*)(hb + 27648);
    const bf16* P = (const bf16*)(A.ws + WS_HP); const float* GT = (const float*)(A.ws + WS_GATES); const float* gb = A.in[10] + l * 8;
    const float* Cb = (const float*)((unsigned char*)A.out + OUT_C); const float* Nb = (const float*)(A.ws + WS_NST); const float* MS = (const float*)(A.ws + WS_MS); bf16* CAT = (bf16*)(A.ws + WS_CAT);
    const float* ng = A.in[11] + l * 256;
    for (int u0 = bidx() * 2; u0 < 4096; u0 += gdim() * 2) {
        const int u = u0 + half, bh = u >> 6, c = u & 63, b = bh >> 2, h = bh & 3;
        { const int s = ht >> 2, d16 = (ht & 3) * 16, pos = c * 64 + s; const size_t prow = ((size_t)b * 4096 + pos) * NPJ;
          float k0[8], k1[8]; conv8(A, l, P, b, pos, 1792 + h * 64 + d16, 256 + h * 64 + d16, k0); conv8(A, l, P, b, pos, 1792 + h * 64 + d16 + 8, 256 + h * 64 + d16 + 8, k1);
          v4u w; w.x = pkbf(k0[0] * 0.125f, k0[1] * 0.125f); w.y = pkbf(k0[2] * 0.125f, k0[3] * 0.125f); w.z = pkbf(k0[4] * 0.125f, k0[5] * 0.125f); w.w = pkbf(k0[6] * 0.125f, k0[7] * 0.125f);
          *(LAS v4u*)(hb + (s * PT + d16) * 2) = w;
          w.x = pkbf(k1[0] * 0.125f, k1[1] * 0.125f); w.y = pkbf(k1[2] * 0.125f, k1[3] * 0.125f); w.z = pkbf(k1[4] * 0.125f, k1[5] * 0.125f); w.w = pkbf(k1[6] * 0.125f, k1[7] * 0.125f);
          *(LAS v4u*)(hb + (s * PT + d16 + 8) * 2) = w;
          const v4u x0 = *(const v4u*)(P + prow + 2048 + h * 64 + d16), x1 = *(const v4u*)(P + prow + 2048 + h * 64 + d16 + 8);
          LAS bf16* vt = (LAS bf16*)(hb + 9216) + d16 * PT + s;
          vt[0 * PT] = (bf16)(x0.x & 0xffff); vt[1 * PT] = (bf16)(x0.x >> 16); vt[2 * PT] = (bf16)(x0.y & 0xffff); vt[3 * PT] = (bf16)(x0.y >> 16);
          vt[4 * PT] = (bf16)(x0.z & 0xffff); vt[5 * PT] = (bf16)(x0.z >> 16); vt[6 * PT] = (bf16)(x0.w & 0xffff); vt[7 * PT] = (bf16)(x0.w >> 16);
          vt[8 * PT] = (bf16)(x1.x & 0xffff); vt[9 * PT] = (bf16)(x1.x >> 16); vt[10 * PT] = (bf16)(x1.y & 0xffff); vt[11 * PT] = (bf16)(x1.y >> 16);
          vt[12 * PT] = (bf16)(x1.z & 0xffff); vt[13 * PT] = (bf16)(x1.z >> 16); vt[14 * PT] = (bf16)(x1.w & 0xffff); vt[15 * PT] = (bf16)(x1.w >> 16);
          const float* cp = Cb + (size_t)u * 4096 + s * 64 + d16;
          const f32x4 c0 = *(const f32x4*)cp, c1 = *(const f32x4*)(cp + 4), c2 = *(const f32x4*)(cp + 8), c3 = *(const f32x4*)(cp + 12);
          w.x = pkbf(c0[0], c0[1]); w.y = pkbf(c0[2], c0[3]); w.z = pkbf(c1[0], c1[1]); w.w = pkbf(c1[2], c1[3]); *(LAS v4u*)(hb + 18432 + (s * PT + d16) * 2) = w;
          w.x = pkbf(c2[0], c2[1]); w.y = pkbf(c2[2], c2[3]); w.z = pkbf(c3[0], c3[1]); w.w = pkbf(c3[2], c3[3]); *(LAS v4u*)(hb + 18432 + (s * PT + d16 + 8) * 2) = w;
          if (ht < 64) tb[256 + ht] = Nb[(size_t)u * 64 + ht]; }
        if (hw == 0) { const size_t row = (size_t)b * 4096 + c * 64 + lane; const float ig = GT[row * 8 + h] + gb[h]; float bc = logsigmoidf_(GT[row * 8 + 4 + h] + gb[4 + h]);
#pragma unroll
            for (int o = 1; o < 64; o <<= 1) { const float nb = __shfl_up(bc, o); if (lane >= o) bc += nb; }
            const float gs = ig - bc; float pm = gs;
#pragma unroll
            for (int o = 1; o < 64; o <<= 1) { const float nb = __shfl_up(pm, o); if (lane >= o) pm = fmaxf(pm, nb); }
            const float mc = MS[u], Mt = fmaxf(mc, pm);
            tb[lane] = gs; tb[64 + lane] = Mt; tb[128 + lane] = __expf(mc - Mt); tb[192 + lane] = __expf(-(bc + Mt)); }
        const int tl = hw * 16 + qi; bf16x8 qf[2]; float nq = 0.f;
        float qv[2][8];
#pragma unroll
        for (int ks = 0; ks < 2; ++ks) { conv8(A, l, P, b, c * 64 + tl, 1536 + h * 64 + ks * 32 + g * 8, h * 64 + ks * 32 + g * 8, qv[ks]);
            v4u w; w.x = pkbf(qv[ks][0], qv[ks][1]); w.y = pkbf(qv[ks][2], qv[ks][3]); w.z = pkbf(qv[ks][4], qv[ks][5]); w.w = pkbf(qv[ks][6], qv[ks][7]); qf[ks] = __builtin_bit_cast(bf16x8, w); }
        __syncthreads();
#pragma unroll
        for (int ks = 0; ks < 2; ++ks) { const f32x4 n0 = *(const LAS f32x4*)(tb + 256 + ks * 32 + g * 8), n1 = *(const LAS f32x4*)(tb + 256 + ks * 32 + g * 8 + 4);
            nq += (qv[ks][0] * n0[0] + qv[ks][1] * n0[1]) + (qv[ks][2] * n0[2] + qv[ks][3] * n0[3]) + (qv[ks][4] * n1[0] + qv[ks][5] * n1[1]) + (qv[ks][6] * n1[2] + qv[ks][7] * n1[3]); }
        nq += __shfl_xor(nq, 16); nq += __shfl_xor(nq, 32);
        const float Mt = tb[64 + tl], inter = tb[128 + tl], emt = tb[192 + tl];
        bf16x8 pf[2]; float dsum = 0.f;
#pragma unroll
        for (int tg = 0; tg < 2; ++tg) { f32x4 sv[2];
#pragma unroll
            for (int j = 0; j < 2; ++j) { sv[j] = (f32x4){0.f, 0.f, 0.f, 0.f}; const int rowp = 32 * tg + 8 * (qi >> 2) + 4 * j + (qi & 3);
#pragma unroll
                for (int ks = 0; ks < 2; ++ks) { const bf16x8 a = *(const LAS bf16x8*)(hb + (rowp * PT + ks * 32 + g * 8) * 2); sv[j] = __builtin_amdgcn_mfma_f32_16x16x32_bf16(a, qf[ks], sv[j], 0, 0, 0); }
                const int s0 = 32 * tg + 8 * g + 4 * j; const f32x4 gsv = *(const LAS f32x4*)(tb + s0);
#pragma unroll
                for (int r = 0; r < 4; ++r) { const float pv = (s0 + r <= tl) ? sv[j][r] * __expf(gsv[r] - Mt) : 0.f; sv[j][r] = pv; dsum += pv; } }
            v4u pw; pw.x = pkbf(sv[0][0], sv[0][1]); pw.y = pkbf(sv[0][2], sv[0][3]); pw.z = pkbf(sv[1][0], sv[1][1]); pw.w = pkbf(sv[1][2], sv[1][3]); pf[tg] = __builtin_bit_cast(bf16x8, pw); }
        dsum += __shfl_xor(dsum, 16); dsum += __shfl_xor(dsum, 32);
        const float den = fmaxf(fabsf(dsum + inter * nq), emt), iden = 1.f / den;
        f32x4 o1[4], o2[4]; float ssq = 0.f;
#pragma unroll
        for (int db = 0; db < 4; ++db) { o1[db] = (f32x4){0.f, 0.f, 0.f, 0.f}; o2[db] = (f32x4){0.f, 0.f, 0.f, 0.f};
#pragma unroll
            for (int tg = 0; tg < 2; ++tg) { const bf16x8 a = *(const LAS bf16x8*)(hb + 9216 + ((db * 16 + qi) * PT + tg * 32 + g * 8) * 2); o1[db] = __builtin_amdgcn_mfma_f32_16x16x32_bf16(a, pf[tg], o1[db], 0, 0, 0); }
#pragma unroll
            for (int ks = 0; ks < 2; ++ks) { const bf16x8 a = *(const LAS bf16x8*)(hb + 18432 + ((db * 16 + qi) * PT + ks * 32 + g * 8) * 2); o2[db] = __builtin_amdgcn_mfma_f32_16x16x32_bf16(a, qf[ks], o2[db], 0, 0, 0); }
            o1[db] = (o1[db] + o2[db] * inter) * iden; ssq += (o1[db][0] * o1[db][0] + o1[db][1] * o1[db][1]) + (o1[db][2] * o1[db][2] + o1[db][3] * o1[db][3]); }
        ssq += __shfl_xor(ssq, 16); ssq += __shfl_xor(ssq, 32);
        const float rs = 1.f / sqrtf(ssq * (1.f / 64.f) + EPS); const size_t row = (size_t)b * 4096 + c * 64 + tl;
#pragma unroll
        for (int db = 0; db < 4; ++db) { const int vcol = h * 64 + db * 16 + 4 * g; const v2u mo = *(const v2u*)(P + row * NPJ + 2304 + vcol); const f32x4 gv = *(const f32x4*)(ng + vcol);
            v2u w; w.x = pkbf(o1[db][0] * rs * gv[0] * sigmoidf_(bflo(mo.x)), o1[db][1] * rs * gv[1] * sigmoidf_(bfhi(mo.x))); w.y = pkbf(o1[db][2] * rs * gv[2] * sigmoidf_(bflo(mo.y)), o1[db][3] * rs * gv[3] * sigmoidf_(bfhi(mo.y)));
            *(v2u*)(CAT + row * DM + 512 + vcol) = w; }
        __syncthreads();
    }
}
__device__ __forceinline__ void s5_scan(CArgs& A, int l) {
    l = lnd(l);
    const int gt = bidx() * 512 + tidx(), NGT = gdim() * 512;
    const float* E = (const float*)(A.ws + WS_EOUT); const float* LAML = (const float*)(A.ws + WS_LAML) + l * LAML_L; bf16* SUX = (bf16*)((unsigned char*)A.out + OUT_SUX);
    for (int idx = gt; idx < 16384; idx += NGT) { const int b = idx >> 10, g = (idx >> 6) & 15, p = idx & 63; const float lr = LAML[2 * (g * 64 + p)], li = LAML[2 * (g * 64 + p) + 1]; float xr = 0.f, xi = 0.f;
        for (int c0 = 0; c0 < 64; c0 += 8) { f32x2 e[8];
#pragma unroll
            for (int j = 0; j < 8; ++j) e[j] = *(const f32x2*)(E + ((size_t)g * 1024 + b * 64 + c0 + j) * 128 + 2 * p);
#pragma unroll
            for (int j = 0; j < 8; ++j) { *(unsigned*)(SUX + ((size_t)g * 1024 + b * 64 + c0 + j) * 1152 + 1024 + 2 * p) = pkbf(xr, xi);
                const float nr = lr * xr - li * xi + e[j].x, ni = lr * xi + li * xr + e[j].y; xr = nr; xi = ni; } } }
}

#define XB_TMO      128
#define XB_XCNT(j)  (256  + 64 * (j))
#define XB_XSUB(j)  (1280 + 64 * (j))
#define XB_XGEN(j)  (2304 + 64 * (j))
#define XB_TOP      3328
#define XB_TOPGEN   3392
#define XCD_BAR_WORDS 3456
#define XB_SPIN_CAP (1u << 18)

__device__ __forceinline__ unsigned xb_ld(unsigned* p)              { return __hip_atomic_load(p, __ATOMIC_RELAXED, __HIP_MEMORY_SCOPE_AGENT); }
__device__ __forceinline__ unsigned xb_add(unsigned* p, unsigned v) { return __hip_atomic_fetch_add(p, v, __ATOMIC_RELAXED, __HIP_MEMORY_SCOPE_AGENT); }
__device__ __forceinline__ unsigned xb_xcc_id() { return (unsigned)__builtin_amdgcn_s_getreg((3 << 11) | 20) & 0xFu; }
#define XB_SPIN(cond, bar) do { unsigned _sp = 0; while (cond) { __builtin_amdgcn_s_sleep(1); \
    if ((++_sp & 255u) == 0u) { if (xb_ld(&(bar)[XB_TMO])) break; if (_sp > XB_SPIN_CAP) { atomicAdd(&(bar)[XB_TMO], 1u); break; } } } } while (0)

struct XcdBarrier {
    unsigned* bar; unsigned x;
    volatile LAS unsigned* st;
};

__device__ __forceinline__ XcdBarrier xcd_barrier_post(unsigned* bar, volatile LAS unsigned* st) {
    XcdBarrier b; b.bar = bar; b.x = xb_xcc_id(); b.st = st;
    if (threadIdx.x == 0) (void)xb_add(&bar[XB_XCNT(b.x)], 1u);
    return b;
}
__device__ __forceinline__ void xcd_barrier_complete(unsigned* bar, unsigned x, unsigned& nloc, unsigned& nx) {
    const unsigned G = gridDim.x * gridDim.y * gridDim.z;
    unsigned sum, cnt, mine, sp = 0u;
    for (;;) {
        sum = 0u; cnt = 0u; mine = 0u;
#pragma unroll
        for (unsigned j = 0; j < 16; ++j) { const unsigned c = xb_ld(&bar[XB_XCNT(j)]); sum += c; cnt += (c > 0u) ? 1u : 0u; mine = (j == x) ? c : mine; }
        if (sum == G) break;
        __builtin_amdgcn_s_sleep(1);
        if ((++sp & 255u) == 0u) { if (xb_ld(&bar[XB_TMO])) break; if (sp > XB_SPIN_CAP) { atomicAdd(&bar[XB_TMO], 1u); break; } }
    }
    nloc = mine > 0u ? mine : 1u; nx = cnt > 0u ? cnt : 1u;
}

__device__ __forceinline__ void xcd_barrier(const XcdBarrier& b) {
    asm volatile("s_waitcnt vmcnt(0)" ::: "memory");
    __syncthreads();
    if (threadIdx.x == 0) {
        unsigned* bar = b.bar;
        __builtin_amdgcn_s_waitcnt(0);
        unsigned nloc = b.st[0], nx = b.st[1];
        if (nloc == 0u) { xcd_barrier_complete(bar, b.x, nloc, nx); b.st[0] = nloc; b.st[1] = nx; }
        const unsigned old = xb_add(&bar[XB_XSUB(b.x)], 1u);
        const unsigned gen = old / nloc;
        if (old + 1u == (gen + 1u) * nloc) {
            __builtin_amdgcn_fence(__ATOMIC_RELEASE, "agent");
            asm volatile("s_waitcnt vmcnt(0)" ::: "memory");
            const unsigned og = xb_add(&bar[XB_TOP], 1u);
            const unsigned tg = og / nx;
            if (og + 1u == (tg + 1u) * nx) xb_add(&bar[XB_TOPGEN], 1u);
            else XB_SPIN(xb_ld(&bar[XB_TOPGEN]) == tg, bar);
            __builtin_amdgcn_fence(__ATOMIC_ACQUIRE, "agent");
            xb_add(&bar[XB_XGEN(b.x)], 1u);
            asm volatile("s_waitcnt vmcnt(0)" ::: "memory");
        } else {
            XB_SPIN(xb_ld(&bar[XB_XGEN(b.x)]) == gen, bar);
            __builtin_amdgcn_fence(__ATOMIC_ACQUIRE, "agent");
            asm volatile("s_waitcnt vmcnt(0)" ::: "memory");
        }
    }
    __syncthreads();
}

#ifndef PHMASK
#define PHMASK 0xFFFFFFFFu
#endif
#ifndef REPMASK
#define REPMASK 0u
#endif
#define REP(k) for (int rep_ = 0; rep_ < 1 + (int)((REPMASK >> (k)) & 1u); ++rep_)
#define A (*kargs())
#define ws (kargs()->ws)
#define Wb ((const bf16*)(ws + WS_W))
#define XB ((bf16*)(ws + WS_XB))
#define CAT ((bf16*)(ws + WS_CAT))
#define HP ((bf16*)(ws + WS_HP))
#define Y ((bf16*)(ws + WS_Y))
#define X (kargs()->out)
#define lng (kargs()->in[5] + lnd(l) * 4096)
#define lnb (kargs()->in[6] + lnd(l) * 4096)
__global__ void __launch_bounds__(512, 2) mega_fwd(Args unused_args) {
    extern __shared__ __attribute__((aligned(16))) unsigned char lds_raw[];
    LAS unsigned char* lds = (LAS unsigned char*)lds_raw;
    cg::grid_group grid = cg::this_grid();
    { volatile LAS unsigned* bst = (volatile LAS unsigned*)(lds + LDS_BYTES - 64); if (tidx() < 16) bst[tidx()] = 0u; __syncthreads();
      (void)xcd_barrier_post((unsigned*)(ws), bst); }
    grid.sync();
#define GSYNC() do { XcdBarrier b_; b_.bar = (unsigned*)(ws); b_.x = xb_xcc_id(); b_.st = (volatile LAS unsigned*)(lds + LDS_BYTES - 64); xcd_barrier(b_); } while (0)
    prep0(A);
    for (int l = 0; l < 2; ++l) {
#if (PHMASK >> 0) & 1
        REP(0)
        layer_prep1(A, lds, l);
#endif
        GSYNC();
#if (PHMASK >> 1) & 1
        REP(1)
        s5_ktab(A, l);
#endif
#if (PHMASK >> 2) & 1
        REP(2)
        { EpiKV E{(bf16*)(ws + WS_KX), (bf16*)(ws + WS_VTX)}; run_gemm(lds, (const bf16*)(ws + WS_MEMB), Wb + WO_KV, 4096, 2048, 1024, 1024, 1024, E); }
#endif
        GSYNC();
#if (PHMASK >> 3) & 1
        REP(3)
        s5_fill(A, l);
#endif
#if (PHMASK >> 4) & 1
        REP(4)
        { const float* rs1_ = (const float*)(ws + (lnd(l) == 0 ? WS_RSTID : WS_RSTAT)); EpiSwiGLU E{HP, LnFold{rs1_, ((const float*)(ws + WS_CC) + (size_t)lnd(l) * CC_L + CC_GU1), ((const float*)(ws + WS_CC) + (size_t)lnd(l) * CC_L + CC_N + CC_GU1)}}; run_gemm<EpiSwiGLU, true>(lds, (const bf16*)Y, Wb + WO_GU1, MT, 5632, 1024, 1024, 1024, E); }
#endif
        GSYNC();
#if (PHMASK >> 5) & 1
        REP(5)
        { const bool first = lnd(l) == 0; const bf16* xr_ = (const bf16*)Y;   const float* rs_ = (const float*)(ws + (first ? WS_RSTID : WS_RSTAT));
          const float* g_ = first ? (const float*)(ws + WS_ONES) : kargs()->in[5] + 3 * 1024; const float* b_ = first ? (const float*)(ws + WS_ZEROS) : kargs()->in[6] + 3 * 1024;
          EpiResid E{xr_, Y, 0.5f, rs_, g_, b_, (float*)(ws + WS_STATP)}; run_gemm(lds, HP, Wb + WO_D1, MT, 1024, 2816, 2816, 2816, E); }
#endif
        GSYNC();
#if (PHMASK >> 6) & 1
        REP(6)
        stat_finalize((float*)(ws + WS_STATP), (float*)(ws + WS_RSTAT));
#endif
        GSYNC();
#if (PHMASK >> 7) & 1
        REP(7)
        { EpiProj E{HP, (bf16*)((unsigned char*)(kargs()->out) + OUT_VT), (bf16*)((unsigned char*)(kargs()->out) + OUT_SUX), (const float*)(ws + WS_ROPE), (const float*)(ws + WS_ROPE) + 4096 * 32, LnFold{(const float*)(ws + WS_RSTAT), ((const float*)(ws + WS_CC) + (size_t)lnd(l) * CC_L + CC_IN), ((const float*)(ws + WS_CC) + (size_t)lnd(l) * CC_L + CC_N + CC_IN)}, (float*)(ws + WS_GATES)}; run_gemm<EpiProj, true>(lds, (const bf16*)Y, Wb + WO_IN, MT, 3072, 1024, 1024, 1024, E); }
#endif
        GSYNC();
#if (PHMASK >> 8) & 1
        REP(8)
        diffattn_phase(A, lds, l);
#endif
#if (PHMASK >> 9) & 1
        REP(9)
        mlstm_local(A, lds, l);
#endif
#if (PHMASK >> 10) & 1
        REP(10)
        { pg8::Gemm g{(const bf16*)((unsigned char*)(kargs()->out) + OUT_SUX), (const bf16*)(ws + WS_EM), 16384, 4096, 1024, 1152, 1024}; GroupOrder S; S.init(16, 4, 1, gdim(), bidx()); EpiS5E E{(float*)(ws + WS_EOUT)};
          pg8::gemm_phase<EpiS5E, GroupOrder, true, true>(lds, g, S, E); }
#endif
        GSYNC();
#if (PHMASK >> 22) & 1
        mlstm_scan(A); s5_scan(A, l);
#endif
        GSYNC();
#if (PHMASK >> 11) & 1
        REP(11)
        mlstm_out(A, lds, l);
#endif
#if (PHMASK >> 12) & 1
        REP(12)
        { pg8::Gemm g{(const bf16*)((unsigned char*)(kargs()->out) + OUT_SUX), (const bf16*)(ws + WS_TF), 16384, 16384, 1152, 1152, 1152}; GroupOrder S; S.init(16, 4, 4, gdim(), bidx()); EpiS5Y E{(bf16*)((unsigned char*)(kargs()->out) + OUT_YS5)};
          pg8::gemm_phase<EpiS5Y, GroupOrder, true, true>(lds, g, S, E); }
#endif
        GSYNC();
#if (PHMASK >> 23) & 1
        REP(23)
        { EpiGLU E{(const bf16*)((unsigned char*)(kargs()->out) + OUT_YS5), A.in[23] + lnd(l) * 256, CAT}; run_gemm(lds, (const bf16*)((unsigned char*)(kargs()->out) + OUT_YS5), Wb + WO_GLU, MT, 256, 256, 256, 256, E); }
#endif
        GSYNC();
#if (PHMASK >> 13) & 1
        REP(13)
        { EpiResid E{Y, Y, 1.0f, (const float*)(float*)(ws + WS_RSTAT), lng, lnb, (float*)(ws + WS_STATP)}; run_gemm(lds, CAT, Wb + WO_OUT, MT, 1024, 1024, 1024, 1024, E); }
#endif
        GSYNC();
#if (PHMASK >> 14) & 1
        REP(14)
        stat_finalize((float*)(ws + WS_STATP), (float*)(ws + WS_RSTAT));
#endif
        GSYNC();
#if (PHMASK >> 15) & 1
        REP(15)
        { EpiBf16 E{HP, LnFold{(const float*)(ws + WS_RSTAT), ((const float*)(ws + WS_CC) + (size_t)lnd(l) * CC_L + CC_Q), ((const float*)(ws + WS_CC) + (size_t)lnd(l) * CC_L + CC_N + CC_Q)}}; run_gemm<EpiBf16, true>(lds, (const bf16*)Y, Wb + WO_Q, MT, 1024, 1024, 1024, 1024, E); }
#endif
        GSYNC();
#if (PHMASK >> 16) & 1
        REP(16)
        xattn_phase(A, lds);
#endif
        GSYNC();
#if (PHMASK >> 17) & 1
        REP(17)
        { EpiResid E{Y, Y, 1.0f, (const float*)(float*)(ws + WS_RSTAT), lng + 1024, lnb + 1024, (float*)(ws + WS_STATP)}; run_gemm(lds, (const bf16*)(ws + WS_HP + 128 * MiB), Wb + WO_O, MT, 1024, 1024, 1024, 1024, E); }
#endif
        GSYNC();
#if (PHMASK >> 18) & 1
        REP(18)
        stat_finalize((float*)(ws + WS_STATP), (float*)(ws + WS_RSTAT));
#endif
        GSYNC();
#if (PHMASK >> 19) & 1
        REP(19)
        { EpiSwiGLU E{HP, LnFold{(const float*)(ws + WS_RSTAT), ((const float*)(ws + WS_CC) + (size_t)lnd(l) * CC_L + CC_GU2), ((const float*)(ws + WS_CC) + (size_t)lnd(l) * CC_L + CC_N + CC_GU2)}}; run_gemm<EpiSwiGLU, true>(lds, (const bf16*)Y, Wb + WO_GU2, MT, 5632, 1024, 1024, 1024, E); }
#endif
        GSYNC();
#if (PHMASK >> 20) & 1
        REP(20)
        { EpiResid E{Y, Y, 0.5f, (const float*)(float*)(ws + WS_RSTAT), lng + 2048, lnb + 2048, (float*)(ws + WS_STATP)}; run_gemm(lds, HP, Wb + WO_D2, MT, 1024, 2816, 2816, 2816, E); }
#endif
        GSYNC();
#if (PHMASK >> 21) & 1
        REP(21)
        if (lnd(l) == 1) ln_phase(Y, lng + 3072, lnb + 3072, X, nullptr, nullptr, nullptr, (float*)(ws + WS_RSTAT));
        else stat_finalize((float*)(ws + WS_STATP), (float*)(ws + WS_RSTAT));
#endif
        GSYNC();
    }
}

#undef ws
#undef Wb
#undef XB
#undef CAT
#undef HP
#undef Y
#undef X
#undef lng
#undef lnb
#undef A
extern "C" void kernel_launch(void* const* d_in, const int* in_sizes, int n_in, void* d_out, int out_size, void* d_ws, size_t ws_size, hipStream_t stream) {
    static int grid = 0;
    if (grid == 0) {
        if (n_in != 28 || out_size != MT * DM || ws_size < WS_END) { fprintf(stderr, "kernel_launch: unexpected problem (n_in %d out %d ws %zu)\n", n_in, out_size, ws_size); grid = -1; return; }
        int dev = 0, cus = 0, per_cu = 0;
        hipGetDevice(&dev); hipDeviceGetAttribute(&cus, hipDeviceAttributeMultiprocessorCount, dev);
        hipFuncSetAttribute((const void*)mega_fwd, hipFuncAttributeMaxDynamicSharedMemorySize, LDS_BYTES);
        hipOccupancyMaxActiveBlocksPerMultiprocessor(&per_cu, (const void*)mega_fwd, 512, LDS_BYTES);
        if (per_cu < 1) per_cu = 1;
        (void)hipGetLastError();
        grid = cus * per_cu;
    }
    if (grid < 0) return;
    if (hipMemsetAsync(d_ws, 0, 327680, stream) != hipSuccess) { fprintf(stderr, "memset failed\n"); return; }
    Args a{};
    for (int i = 0; i < 28; ++i) a.in[i] = (const float*)d_in[i];
    a.out = (float*)d_out; a.ws = (unsigned char*)d_ws;
    void* args[] = {&a};
    hipError_t e = hipLaunchCooperativeKernel((const void*)mega_fwd, dim3(grid), dim3(512), args, LDS_BYTES, stream);
    if (e != hipSuccess) fprintf(stderr, "cooperative launch failed: %s (grid %d)\n", hipGetErrorString(e), grid);
}
```

```cpp
#include <hip/hip_runtime.h>
#include <hip/hip_cooperative_groups.h>
#include <cstdio>
#include <cstdint>
namespace cg = cooperative_groups;
__device__ __forceinline__ int tidx() { int t = threadIdx.x; asm volatile("" : "+v"(t)); return t; }
__device__ __forceinline__ int bidx() { int t = blockIdx.x; asm volatile("" : "+s"(t)); return t; }
__device__ __forceinline__ int gdim() { int t = gridDim.x; asm volatile("" : "+s"(t)); return t; }
__device__ __forceinline__ int lnd(int v) { asm volatile("" : "+s"(v)); return v; }
namespace pg8 {
#define PG8_LAS __attribute__((address_space(3)))
typedef unsigned short bf16_t;
typedef short bf16x8 __attribute__((ext_vector_type(8)));
typedef float f32x4 __attribute__((ext_vector_type(4)));
typedef unsigned u32x4 __attribute__((ext_vector_type(4)));
constexpr int BM = 256, BK = 64, HALF = 128, HTB = HALF * BK * 2  , STAGE_BYTES = 8 * HTB, NXCD = 8, WGM = 8;

__host__ __device__ __forceinline__ int lds_byte(int r, int c) { const int st = (r >> 4) * 2 + (c >> 5), rr = r & 15, cc = c & 31, ob = rr * 64 + cc * 2; return st * 1024 + (ob ^ (((ob >> 9) & 1) << 5)); }
__host__ __device__ __forceinline__ void stage_rc(int b, int& R, int& C) { const int st = b / 1024, sb = b % 1024, swz = sb ^ (((sb >> 9) & 1) << 5); R = (st >> 1) * 16 + swz / 64; C = (st & 1) * 32 + (swz % 64) / 2; }
__host__ __device__ __forceinline__ int perm32(int rho) { const int n = rho >> 4, i = rho & 15; return 8 * (i >> 2) + 4 * n + (i & 3); }

struct Unit { int pm, pn; };
struct Gemm { const bf16_t* A; const bf16_t* Bt; int M, N, K, lda, ldb; };

struct StaticOrder {
    int nM, nN, nwg, G, c;
    __host__ __device__ void init(int M, int N, int G_, int c_) { nM = M / BM; nN = N / BM; nwg = nM * nN; G = G_; c = c_; }
    __host__ __device__ bool next(int i, Unit& u) const {
        const long L = (long)i * G + c; if (L >= nwg) return false;
        int wgid = (int)L; { const int q = nwg / NXCD, r = nwg % NXCD, xcd = wgid % NXCD, off = wgid / NXCD; wgid = (xcd < r ? xcd * (q + 1) : r * (q + 1) + (xcd - r) * q) + off; }
        const int nig = WGM * nN, gid = wgid / nig, fm = gid * WGM, gsz = (nM - fm) < WGM ? (nM - fm) : WGM;
        u.pm = fm + ((wgid % nig) % gsz); u.pn = (wgid % nig) / gsz; return true;
    }
    __device__ __forceinline__ void a_ready(const Unit&) const {}
    __device__ __forceinline__ void done(const Unit&) const {}
};

__device__ __forceinline__ unsigned cvt_pk_bf16(float lo, float hi) { unsigned r; asm volatile("v_cvt_pk_bf16_f32 %0, %1, %2" : "=v"(r) : "v"(lo), "v"(hi)); return r; }
typedef float f32x2 __attribute__((ext_vector_type(2)));
typedef _Float16 f16x8_t __attribute__((ext_vector_type(8)));
template <bool F16> __device__ __forceinline__ f32x4 mma16(bf16x8 a, bf16x8 b, f32x4 c) {
    if constexpr (F16) return __builtin_amdgcn_mfma_f32_16x16x32_f16(__builtin_bit_cast(f16x8_t, a), __builtin_bit_cast(f16x8_t, b), c, 0, 0, 0);
    else return __builtin_amdgcn_mfma_f32_16x16x32_bf16(a, b, c, 0, 0, 0);
}
template <class Epi, class Sched, bool ALIGN_EPI = false, bool SP2 = false, bool F16 = false>
__device__ __forceinline__ void gemm_phase(PG8_LAS unsigned char* lds, const Gemm g, const Sched& S, const Epi& E) {
    const int tid = tidx(), wid = __builtin_amdgcn_readfirstlane(tid >> 6), lane = tid & 63, wr = wid >> 2, wc = wid & 3, fr = lane & 15, fq = lane >> 4;
    const int K = g.K, nt = K / BK, lda = g.lda, ldb = g.ldb;
    unsigned voffA[2], voffB[2];
#pragma unroll
    for (int i = 0; i < 2; ++i) { int R, C; stage_rc(tid * 16 + i * 8192, R, C); const int Rb = Epi::PERM ? ((R & ~31) + perm32(R & 31)) : R;
        voffA[i] = (unsigned)(R * lda + C) * 2u; voffB[i] = (unsigned)(Rb * ldb + C) * 2u; }
    const size_t kstep = (size_t)(BK * 2);
    const size_t hstepA = (size_t)HALF * lda * 2, hstepB = (size_t)HALF * ldb * 2;
    const size_t tstepA = 2 * hstepA, tstepB = 2 * hstepB;
    const unsigned ldsw = (unsigned)wid * 1024u;
    const int aoff = lds_byte(wr * 64 + fr, fq * 8), boff = lds_byte(wc * 32 + fr, fq * 8);
#define PG8_SA(b, h) (((b) * 2 + (h)) * HTB)
#define PG8_SB(b, h) ((4 + (b) * 2 + (h)) * HTB)
#define PG8_STAGE(bufoff, gbase, voff) do { _Pragma("unroll") for (int _i = 0; _i < 2; ++_i) \
        __builtin_amdgcn_global_load_lds((const unsigned*)((const char*)(gbase) + (voff)[_i]), (PG8_LAS unsigned*)(lds + (bufoff) + ldsw + _i * 8192), 16, 0, 0); } while (0)
#define PG8_LDA(dst, b, h) do { _Pragma("unroll") for (int m = 0; m < 4; ++m) _Pragma("unroll") for (int k = 0; k < 2; ++k) dst[m][k] = *(const PG8_LAS bf16x8*)(lds + PG8_SA(b, h) + aoff + m * 2048 + k * 1024); } while (0)
#define PG8_LDB(dst, b, h) do { _Pragma("unroll") for (int n = 0; n < 2; ++n) _Pragma("unroll") for (int k = 0; k < 2; ++k) dst[n][k] = *(const PG8_LAS bf16x8*)(lds + PG8_SB(b, h) + boff + n * 2048 + k * 1024); } while (0)
#define PG8_MMA(ai, bj, At, Bt) do { __builtin_amdgcn_s_setprio(1); _Pragma("unroll") for (int m = 0; m < 4; ++m) _Pragma("unroll") for (int n = 0; n < 2; ++n) _Pragma("unroll") for (int k = 0; k < 2; ++k) \
        acc[ai][bj][m][n] = mma16<F16>(Bt[n][k], At[m][k], acc[ai][bj][m][n]); __builtin_amdgcn_s_setprio(0); } while (0)
#define PG8_WAIT_V(n) asm volatile("s_waitcnt vmcnt(" #n ")" ::: "memory")
#define PG8_WAIT_L(n) asm volatile("s_waitcnt lgkmcnt(" #n ")" ::: "memory")
#define PG8_BAR __builtin_amdgcn_s_barrier()
#define PG8_SCHED __builtin_amdgcn_sched_barrier(0)
    Unit cur, nxt; int ui = 0;
    if (!S.next(0, cur)) return;
    f32x4 acc[2][2][4][2];
#pragma unroll
    for (int a = 0; a < 2; ++a)
#pragma unroll
        for (int b = 0; b < 2; ++b)
#pragma unroll
            for (int m = 0; m < 4; ++m)
#pragma unroll
                for (int n = 0; n < 2; ++n) acc[a][b][m][n] = (f32x4){0.f, 0.f, 0.f, 0.f};
    bf16x8 At[4][2], B0[2][2], B1[2][2];
    const char* cA = (const char*)g.A + (size_t)cur.pm * tstepA; const char* cB = (const char*)g.Bt + (size_t)cur.pn * tstepB;
    S.a_ready(cur);
    if constexpr (SP2) {
        PG8_STAGE(PG8_SB(0, 0), cB, voffB); PG8_STAGE(PG8_SB(0, 1), cB + hstepB, voffB); PG8_STAGE(PG8_SA(0, 0), cA, voffA); PG8_STAGE(PG8_SA(0, 1), cA + hstepA, voffA);
        if (wr == 1) PG8_BAR;
        PG8_WAIT_V(2); PG8_BAR;
        PG8_STAGE(PG8_SB(1, 0), cB + kstep, voffB); PG8_STAGE(PG8_SA(1, 0), cA + kstep, voffA); PG8_STAGE(PG8_SB(1, 1), cB + hstepB + kstep, voffB);
        PG8_WAIT_V(6); PG8_BAR;
    } else {
        PG8_STAGE(PG8_SB(0, 0), cB, voffB); PG8_STAGE(PG8_SA(0, 0), cA, voffA); PG8_STAGE(PG8_SB(0, 1), cB + hstepB, voffB); PG8_STAGE(PG8_SA(0, 1), cA + hstepA, voffA);
        if (wr == 1) PG8_BAR;
        PG8_WAIT_V(4); PG8_BAR;
        PG8_STAGE(PG8_SB(1, 0), cB + kstep, voffB); PG8_STAGE(PG8_SA(1, 0), cA + kstep, voffA); PG8_STAGE(PG8_SB(1, 1), cB + hstepB + kstep, voffB);
        PG8_WAIT_V(6); PG8_BAR;
    }
    for (;;) {
        const bool has_next = S.next(ui + 1, nxt);
        const char* nA = has_next ? (const char*)g.A + (size_t)nxt.pm * tstepA : cA; const char* nB = has_next ? (const char*)g.Bt + (size_t)nxt.pn * tstepB : cB;
        for (int t = 0; t < nt; t += 2) {
            const bool last = (t == nt - 2);
            const char* a1 = cA + (size_t)(t + 1) * kstep;
            const char* a2 = last ? nA : cA + (size_t)(t + 2) * kstep; const char* b2 = last ? nB : cB + (size_t)(t + 2) * kstep;
            const char* a3 = a2 + kstep; const char* b3 = b2 + kstep;
            if (last && has_next) S.a_ready(nxt);
            if constexpr (SP2) {
            PG8_LDB(B0, 0, 0); PG8_LDB(B1, 0, 1); PG8_SCHED; PG8_LDA(At, 0, 0); PG8_STAGE(PG8_SA(1, 1), a1 + hstepA, voffA);
            PG8_WAIT_V(8); PG8_WAIT_L(0); PG8_BAR; PG8_MMA(0, 0, At, B0); PG8_MMA(0, 1, At, B1); PG8_BAR; PG8_SCHED;
            PG8_LDA(At, 0, 1); PG8_STAGE(PG8_SB(0, 0), b2, voffB); PG8_STAGE(PG8_SB(0, 1), b2 + hstepB, voffB); PG8_STAGE(PG8_SA(0, 0), a2, voffA);
            PG8_WAIT_V(8); PG8_WAIT_L(0); PG8_BAR; PG8_MMA(1, 0, At, B0); PG8_MMA(1, 1, At, B1); PG8_BAR; PG8_SCHED;
            PG8_LDB(B0, 1, 0); PG8_LDB(B1, 1, 1); PG8_SCHED; PG8_LDA(At, 1, 0); PG8_STAGE(PG8_SA(0, 1), a2 + hstepA, voffA);
            PG8_WAIT_V(8); PG8_WAIT_L(0); PG8_BAR; PG8_MMA(0, 0, At, B0); PG8_MMA(0, 1, At, B1); PG8_BAR; PG8_SCHED;
            PG8_LDA(At, 1, 1); PG8_STAGE(PG8_SB(1, 0), b3, voffB); PG8_STAGE(PG8_SB(1, 1), b3 + hstepB, voffB); PG8_STAGE(PG8_SA(1, 0), a3, voffA);
            PG8_WAIT_V(8); PG8_WAIT_L(0); PG8_BAR; PG8_MMA(1, 0, At, B0); PG8_MMA(1, 1, At, B1); PG8_BAR; PG8_SCHED;
            } else {
            PG8_LDB(B0, 0, 0); PG8_SCHED; PG8_LDA(At, 0, 0); PG8_STAGE(PG8_SA(1, 1), a1 + hstepA, voffA);
            PG8_WAIT_L(8); PG8_BAR; PG8_WAIT_L(0); PG8_MMA(0, 0, At, B0); PG8_BAR; PG8_SCHED;
            PG8_LDB(B1, 0, 1); PG8_STAGE(PG8_SB(0, 0), b2, voffB);
            PG8_BAR; PG8_WAIT_L(0); PG8_MMA(0, 1, At, B1); PG8_BAR;
            PG8_LDA(At, 0, 1); PG8_STAGE(PG8_SA(0, 0), a2, voffA);
            PG8_BAR; PG8_WAIT_L(0); PG8_MMA(1, 0, At, B0); PG8_BAR; PG8_SCHED;
            PG8_STAGE(PG8_SB(0, 1), b2 + hstepB, voffB);
            PG8_WAIT_V(6); PG8_BAR; PG8_MMA(1, 1, At, B1); PG8_BAR;
            PG8_LDB(B0, 1, 0); PG8_SCHED; PG8_LDA(At, 1, 0); PG8_STAGE(PG8_SA(0, 1), a2 + hstepA, voffA);
            PG8_WAIT_L(8); PG8_BAR; PG8_WAIT_L(0); PG8_MMA(0, 0, At, B0); PG8_BAR; PG8_SCHED;
            PG8_LDB(B1, 1, 1); PG8_STAGE(PG8_SB(1, 0), b3, voffB);
            PG8_BAR; PG8_WAIT_L(0); PG8_MMA(0, 1, At, B1); PG8_BAR;
            PG8_LDA(At, 1, 1); PG8_STAGE(PG8_SA(1, 0), a3, voffA);
            PG8_BAR; PG8_WAIT_L(0); PG8_MMA(1, 0, At, B0); PG8_BAR; PG8_SCHED;
            PG8_STAGE(PG8_SB(1, 1), b3 + hstepB, voffB);
            PG8_WAIT_V(6); PG8_BAR; PG8_MMA(1, 1, At, B1); PG8_BAR;
            }
        }
        if constexpr (ALIGN_EPI) { if (wr == 0) PG8_BAR; }
        if constexpr (!Epi::AFTER_DRAIN) { E(acc, cur, wr, wc, fr, fq); S.done(cur); }
        if (!has_next) break;
#pragma unroll
        for (int a = 0; a < 2; ++a)
#pragma unroll
            for (int b = 0; b < 2; ++b)
#pragma unroll
                for (int m = 0; m < 4; ++m)
#pragma unroll
                    for (int n = 0; n < 2; ++n) acc[a][b][m][n] = (f32x4){0.f, 0.f, 0.f, 0.f};
        cur = nxt; cA = nA; cB = nB; ++ui;
        if constexpr (ALIGN_EPI) { if (wr == 1) PG8_BAR; }
    }
    PG8_WAIT_V(0);
    if constexpr (!ALIGN_EPI) { if (wr == 0) PG8_BAR; }
    PG8_BAR;
    if constexpr (Epi::AFTER_DRAIN) { E.fused(acc, cur, wr, wc, fr, fq, lds, wid, lane); S.done(cur); }
#undef PG8_SA
#undef PG8_SB
#undef PG8_STAGE
#undef PG8_LDA
#undef PG8_LDB
#undef PG8_MMA
#undef PG8_WAIT_V
#undef PG8_WAIT_L
#undef PG8_BAR
#undef PG8_SCHED
}
}

#define LAS __attribute__((address_space(3)))
typedef unsigned short bf16;
typedef unsigned v4u __attribute__((ext_vector_type(4)));
typedef unsigned v2u __attribute__((ext_vector_type(2)));
typedef float f32x4 __attribute__((ext_vector_type(4)));
typedef float f32x2 __attribute__((ext_vector_type(2)));
typedef short bf16x8 __attribute__((ext_vector_type(8)));
using pg8::Unit;

constexpr int SEQ = 4096, NB = 16, DM = 1024, MT = NB * SEQ, DFF = 2816, DINW = 2824, NPJ = 2816;
constexpr float ALPHA = 1.41421356237309515f, EPS = 1e-5f, LOG2E = 1.4426950408889634f;
constexpr size_t MiB = 1u << 20;
constexpr size_t WS_ROPE = 1 * MiB, WS_GATES = 2 * MiB, WS_WG = 4 * MiB, WS_MEMB = 5 * MiB, WS_W = 16 * MiB, WS_TF = 68 * MiB, WS_EM = 104 * MiB,
    WS_KX = 112 * MiB, WS_VTX = 120 * MiB, WS_XB = 128 * MiB, WS_CAT = 256 * MiB, WS_HP = 384 * MiB, WS_Y = 736 * MiB,
    WS_NST = 992 * MiB, WS_AB = 993 * MiB, WS_MS = 993 * MiB + 512 * 1024, WS_EOUT = 994 * MiB, WS_POW = 1002 * MiB, WS_BBAR = 1004 * MiB,
    WS_KTAB = 1005 * MiB, WS_LAML = 1006 * MiB, WS_END = 1009 * MiB;
constexpr int POW_L = 147456, BBAR_L = 32768, LAML_L = 2048;
constexpr size_t WO_GU1 = 0, WO_D1 = WO_GU1 + 5632u * 1024, WO_GU2 = WO_D1 + 1024u * 2816, WO_D2 = WO_GU2 + 5632u * 1024, WO_IN = WO_D2 + 1024u * 2816,
    WO_OUT = WO_IN + 3072u * 1024, WO_Q = WO_OUT + 1024u * 1024, WO_KV = WO_Q + 1024u * 1024, WO_O = WO_KV + 2048u * 1024, WO_GLU = WO_O + 1024u * 1024,
    WO_END = WO_GLU + 256u * 256;
static_assert(WO_END * 2 <= 52 * MiB, "weights fit");
constexpr size_t OUT_VT = 0, OUT_C = 64 * MiB, OUT_SUX = 128 * MiB, OUT_YS5 = 164 * MiB;
constexpr size_t WS_RSTAT = 1007 * MiB, WS_RSTID = 1007 * MiB + 512 * 1024, WS_ONES = 1008 * MiB, WS_ZEROS = 1008 * MiB + 4096;
constexpr size_t WS_CC = 65536, CC_L = 30720;
constexpr int CC_GU1 = 0, CC_IN = 5632, CC_Q = 8704, CC_GU2 = 9728, CC_N = 15360;
constexpr size_t WS_STATP = 128 * MiB;
constexpr int LDS_BYTES = 147456;

struct Args { const float* in[28]; float* out; unsigned char* ws; };
typedef const __attribute__((address_space(4))) Args CArgs;
__device__ __forceinline__ CArgs* kargs() { CArgs* p = (CArgs*)__builtin_amdgcn_kernarg_segment_ptr(); asm volatile("" : "+s"(p)); return p; }

__device__ __forceinline__ unsigned pkbf(float lo, float hi) { return pg8::cvt_pk_bf16(lo, hi); }
__device__ __forceinline__ float bf2f(unsigned short b) { return __uint_as_float(((unsigned)b) << 16); }
__device__ __forceinline__ float bflo(unsigned w) { return __uint_as_float(w << 16); }
__device__ __forceinline__ float bfhi(unsigned w) { return __uint_as_float(w & 0xffff0000u); }
typedef _Float16 h16x2 __attribute__((ext_vector_type(2)));
__device__ __forceinline__ unsigned pkh(float lo, float hi) { h16x2 v; v.x = (_Float16)lo; v.y = (_Float16)hi; return __builtin_bit_cast(unsigned, v); }
__device__ __forceinline__ float hlo(unsigned w) { return (float)__builtin_bit_cast(h16x2, w).x; }
__device__ __forceinline__ float hhi(unsigned w) { return (float)__builtin_bit_cast(h16x2, w).y; }
__device__ __forceinline__ float wave_sum(float v) {
#pragma unroll
    for (int o = 1; o < 64; o <<= 1) v += __shfl_xor(v, o);
    return v;
}
__device__ __forceinline__ float wave_max(float v) {
#pragma unroll
    for (int o = 1; o < 64; o <<= 1) v = fmaxf(v, __shfl_xor(v, o));
    return v;
}
__device__ __forceinline__ float sigmoidf_(float x) { return __builtin_amdgcn_rcpf(1.f + __expf(-x)); }
__device__ __forceinline__ float siluf_(float x) { return x * sigmoidf_(x); }
__device__ __forceinline__ float gelu_tanh(float x) { const float u = x * (1.5957691216057308f + 0.07135481627f * x * x); return x * __builtin_amdgcn_rcpf(1.f + __expf(-u)); }
#define LDS_WAIT() asm volatile("s_waitcnt lgkmcnt(0)" ::: "memory")

__device__ __forceinline__ void sincos_d(double x, double& s, double& c) {
    const double TWO_PI = 6.283185307179586476925286766559;
    const double n = rint(x / TWO_PI);
    const double r = x - n * TWO_PI, r2 = r * r;
    double ts = r, tc = 1.0; s = r; c = 1.0;
#pragma unroll 1
    for (int k = 1; k <= 16; ++k) { tc = -tc * r2 / (double)((2 * k - 1) * (2 * k)); c += tc; ts = -ts * r2 / (double)((2 * k) * (2 * k + 1)); s += ts; }
}

__device__ __forceinline__ void tr_block(const float* W, int ldw, int k0, int c0, bf16* WT, int ldt, int n0, LAS float* scr, int lane, bool fold, const float* gk, const float* bk, float* c1, float* c2, int nvalid) {
#pragma unroll 8
    for (int i = 0; i < 32; ++i) { const int kk = 2 * i + (lane >> 5); scr[kk * 33 + (lane & 31)] = W[(size_t)(k0 + kk) * ldw + c0 + (lane & 31)]; }
    LDS_WAIT(); asm volatile("" ::: "memory");
    const int c = lane & 7;
    if (!fold) {
#pragma unroll
        for (int j = 0; j < 4; ++j) { const int n = (lane >> 3) + 8 * j; const LAS float* s = scr + (8 * c) * 33 + n;
            v4u o; o.x = pkbf(s[0 * 33], s[1 * 33]); o.y = pkbf(s[2 * 33], s[3 * 33]); o.z = pkbf(s[4 * 33], s[5 * 33]); o.w = pkbf(s[6 * 33], s[7 * 33]);
            *(v4u*)(WT + (size_t)(n0 + n) * ldt + k0 + 8 * c) = o; }
    } else {
        float gv[8], bv[8];
#pragma unroll
        for (int i = 0; i < 8; ++i) { gv[i] = gk ? gk[k0 + 8 * c + i] : 1.f; bv[i] = bk ? bk[k0 + 8 * c + i] : 0.f; }
#pragma unroll
        for (int j = 0; j < 4; ++j) { const int n = (lane >> 3) + 8 * j; const LAS float* s = scr + (8 * c) * 33 + n; const float live = n < nvalid ? 1.f : 0.f;
            float w[8]; float p2 = 0.f;
#pragma unroll
            for (int i = 0; i < 8; ++i) { const float raw = s[i * 33] * live; w[i] = raw * gv[i]; p2 += raw * bv[i]; }
            v4u o; o.x = pkh(w[0], w[1]); o.y = pkh(w[2], w[3]); o.z = pkh(w[4], w[5]); o.w = pkh(w[6], w[7]);
            *(v4u*)(WT + (size_t)(n0 + n) * ldt + k0 + 8 * c) = o;
            float p1 = ((hlo(o.x) + hhi(o.x)) + (hlo(o.y) + hhi(o.y))) + ((hlo(o.z) + hhi(o.z)) + (hlo(o.w) + hhi(o.w)));
            p1 += __shfl_xor(p1, 1); p1 += __shfl_xor(p1, 2); p1 += __shfl_xor(p1, 4); p2 += __shfl_xor(p2, 1); p2 += __shfl_xor(p2, 2); p2 += __shfl_xor(p2, 4);
            if (c == 0) { atomicAdd(c1 + n0 + n, p1); atomicAdd(c2 + n0 + n, p2); } }
    }
    LDS_WAIT(); asm volatile("" ::: "memory");
}
__device__ __forceinline__ void tr_job(const float* W, const float* W2, int ldw, int K, int ndest, bf16* WT, int mode, LAS float* scr, int gw, int NGW, int lane,
                                       bool fold = false, const float* gk = nullptr, const float* bk = nullptr, float* c1 = nullptr, float* c2 = nullptr) {
    const int nb = ndest / 32, items = (K / 64) * nb;
    for (int it = gw; it < items; it += NGW) {
        const int kb = it / nb, n0 = (it % nb) * 32; const float* src = W; int c0 = n0, nvalid = 32;
        if (mode == 1) { const int pn = n0 >> 8, bj = (n0 >> 7) & 1, cc = n0 & 127; src = bj ? W2 : W; c0 = 128 * pn + cc; }
        else if (mode == 2) { if (n0 < 1024) { const int pn = n0 >> 8, half = (n0 >> 7) & 1, v = (n0 >> 5) & 3; c0 = 256 * pn + 64 * v + 32 * half; } else if (n0 >= 2816) { c0 = 2560; nvalid = n0 == 2816 ? 8 : 0; } else if (n0 >= 2560) c0 = n0 + 8; }
        tr_block(src, ldw, kb * 64, c0, WT, K, n0, scr, lane, fold, gk, bk, c1, c2, nvalid);
    }
}

__device__ __forceinline__ void layer_prep1(CArgs& A, LAS unsigned char* lds, int l) {
    l = lnd(l);
    const int tid = tidx(), lane = tid & 63, wave = tid >> 6, G = gdim(), bid = bidx();
    const int gw = bid * 8 + wave, NGW = G * 8, gt = bid * 512 + tid, NGT = G * 512;
    LAS float* scr = (LAS float*)(lds + wave * 16384);
    bf16* Wb = (bf16*)(A.ws + WS_W);
    const size_t f1 = (size_t)1024 * 2816;
    float* c1v = (float*)(A.ws + WS_CC) + (size_t)l * CC_L; float* c2v = c1v + CC_N;
    const float* lg = A.in[5] + l * 4096; const float* lb = A.in[6] + l * 4096;
    tr_job(A.in[2] + (size_t)(l * 2 + 0) * f1, A.in[3] + (size_t)(l * 2 + 0) * f1, 2816, 1024, 5632, Wb + WO_GU1, 1, scr, gw, NGW, lane, true, l ? lg - 1024 : nullptr, l ? lb - 1024 : nullptr, c1v + CC_GU1, c2v + CC_GU1);
    tr_job(A.in[2] + (size_t)(l * 2 + 1) * f1, A.in[3] + (size_t)(l * 2 + 1) * f1, 2816, 1024, 5632, Wb + WO_GU2, 1, scr, gw, NGW, lane, true, lg + 2048, lb + 2048, c1v + CC_GU2, c2v + CC_GU2);
    tr_job(A.in[4] + (size_t)(l * 2 + 0) * f1, nullptr, 1024, 2816, 1024, Wb + WO_D1, 0, scr, gw, NGW, lane);
    tr_job(A.in[4] + (size_t)(l * 2 + 1) * f1, nullptr, 1024, 2816, 1024, Wb + WO_D2, 0, scr, gw, NGW, lane);
    tr_job(A.in[7] + (size_t)l * 1024 * DINW, nullptr, DINW, 1024, 3072, Wb + WO_IN, 2, scr, gw, NGW, lane, true, lg, lb, c1v + CC_IN, c2v + CC_IN);
    tr_job(A.in[24] + (size_t)l * 1024 * 1024, nullptr, 1024, 1024, 1024, Wb + WO_OUT, 0, scr, gw, NGW, lane);
    tr_job(A.in[25] + (size_t)l * 1024 * 1024, nullptr, 1024, 1024, 1024, Wb + WO_Q, 0, scr, gw, NGW, lane, true, lg + 1024, lb + 1024, c1v + CC_Q, c2v + CC_Q);
    tr_job(A.in[26] + (size_t)l * 1024 * 2048, nullptr, 2048, 1024, 2048, Wb + WO_KV, 0, scr, gw, NGW, lane);
    tr_job(A.in[27] + (size_t)l * 1024 * 1024, nullptr, 1024, 1024, 1024, Wb + WO_O, 0, scr, gw, NGW, lane);
    tr_job(A.in[22] + (size_t)l * 256 * 256, nullptr, 256, 256, 256, Wb + WO_GLU, 0, scr, gw, NGW, lane);
}
__device__ __forceinline__ void prep0(CArgs& A) {
    const int tid = tidx(), G = gdim(), bid = bidx(); const int gt = bid * 512 + tid, NGT = G * 512;
    for (int l = 0; l < 2; ++l) {
    { float* POW = (float*)(A.ws + WS_POW) + l * POW_L; float* BBAR = (float*)(A.ws + WS_BBAR) + l * BBAR_L; float* LAML = (float*)(A.ws + WS_LAML) + l * LAML_L;
      const float* are = A.in[14] + l * 1024; const float* aim = A.in[15] + l * 1024; const float* lst = A.in[16] + l * 16;
      const float* bre = A.in[17] + (size_t)l * 16384; const float* bim = A.in[18] + (size_t)l * 16384;
      for (int i = gt; i < 16 * 65 * 64; i += NGT) { const int g = i / (65 * 64), tau = (i >> 6) % 65, p = i & 63;
          const double step = exp((double)lst[g]); const double ar = (double)are[g * 64 + p], ai = (double)aim[g * 64 + p];
          const double mag = exp((double)tau * ar * step); double s, c; sincos_d((double)tau * ai * step, s, c);
          POW[2 * i] = (float)(mag * c); POW[2 * i + 1] = (float)(mag * s);
          if (tau == 64) { LAML[2 * (g * 64 + p)] = (float)(mag * c); LAML[2 * (g * 64 + p) + 1] = (float)(mag * s); } }
      for (int i = gt; i < 16 * 64 * 16; i += NGT) { const int g = i >> 10, p = (i >> 4) & 63;
          const double step = exp((double)lst[g]); const double ar = (double)are[g * 64 + p], ai = (double)aim[g * 64 + p];
          const double mag = exp(ar * step); double s, c; sincos_d(ai * step, s, c);
          const double lr = mag * c - 1.0, li = mag * s, den = ar * ar + ai * ai;
          const double zr = (lr * ar + li * ai) / den, zi = (li * ar - lr * ai) / den;
          const double br = (double)bre[i], bi = (double)bim[i];
          BBAR[2 * i] = (float)(zr * br - zi * bi); BBAR[2 * i + 1] = (float)(zr * bi + zi * br); } }
    }
    {
        float* RC = (float*)(A.ws + WS_ROPE); float* RS = RC + 4096 * 32;
        for (int i = gt; i < 4096 * 32; i += NGT) { const int pos = i >> 5, k = i & 31;
            const float inv = (float)exp(-(double)(2 * k) / 64.0 * 9.210340371976184); const float ang = (float)pos * inv;
            double s, c; sincos_d((double)ang, s, c); RC[i] = (float)c; RS[i] = (float)s; }
        { float* rid = (float*)(A.ws + WS_RSTID); for (int i = gt; i < 2 * MT; i += NGT) rid[i] = (i & 1) ? 1.f : 0.f;
          float* on = (float*)(A.ws + WS_ONES); float* ze = (float*)(A.ws + WS_ZEROS); for (int i = gt; i < 1024; i += NGT) { on[i] = 1.f; ze[i] = 0.f; } }
        { const f32x4* x4 = (const f32x4*)A.in[0]; v2u* oh = (v2u*)(A.ws + WS_Y);
          for (size_t i = gt; i < (size_t)MT * DM / 4; i += NGT) { const f32x4 v = x4[i]; v2u h; h.x = pkh(v.x, v.y); h.y = pkh(v.z, v.w); oh[i] = h; } }
        { const f32x4* x4 = (const f32x4*)A.in[1]; v2u* o = (v2u*)(A.ws + WS_MEMB);
          for (size_t i = gt; i < (size_t)4096 * DM / 4; i += NGT) { const f32x4 v = x4[i]; v2u w; w.x = pkbf(v.x, v.y); w.y = pkbf(v.z, v.w); o[i] = w; } }
    }
}
__device__ __forceinline__ void s5_ktab(CArgs& A, int l) {
    l = lnd(l);
    const int gt = bidx() * 512 + tidx(), NGT = gdim() * 512;
    const float* POW = (const float*)(A.ws + WS_POW) + l * POW_L; const float* BBAR = (const float*)(A.ws + WS_BBAR) + l * BBAR_L; float* KT = (float*)(A.ws + WS_KTAB);
    const float* cre = A.in[19] + (size_t)l * 16384; const float* cim = A.in[20] + (size_t)l * 16384;
    for (int i = gt; i < 16 * 64 * 256; i += NGT) { const int g = i >> 14, tau = (i >> 8) & 63, co = (i >> 4) & 15, ci = i & 15; float acc = 0.f;
        for (int p = 0; p < 64; ++p) { const float cr = cre[(g * 16 + co) * 64 + p], cm = cim[(g * 16 + co) * 64 + p];
            const f32x2 P = *(const f32x2*)(POW + 2 * ((g * 65 + tau) * 64 + p)); const f32x2 B = *(const f32x2*)(BBAR + 2 * ((g * 64 + p) * 16 + ci));
            const float zr = P.x * B.x - P.y * B.y, zi = P.x * B.y + P.y * B.x; acc += cr * zr - cm * zi; }
        KT[i] = acc; }
}
__device__ __forceinline__ void s5_fill(CArgs& A, int l) {
    l = lnd(l);
    const int gt = bidx() * 512 + tidx(), NGT = gdim() * 512;
    const float* POW = (const float*)(A.ws + WS_POW) + l * POW_L; const float* BBAR = (const float*)(A.ws + WS_BBAR) + l * BBAR_L; const float* KT = (const float*)(A.ws + WS_KTAB);
    const float* cre = A.in[19] + (size_t)l * 16384; const float* cim = A.in[20] + (size_t)l * 16384; const float* Dk = A.in[21] + l * 256;
    bf16* TF = (bf16*)(A.ws + WS_TF); bf16* EM = (bf16*)(A.ws + WS_EM);
    for (int i = gt; i < 16384 * 144; i += NGT) { const int row = i / 144, k8 = i % 144, g = row >> 10, t = (row >> 4) & 63, co = row & 15; float v[8];
        if (k8 < 128) { const int s = k8 >> 1, ci0 = (k8 & 1) * 8;
#pragma unroll
            for (int j = 0; j < 8; ++j) { const int ci = ci0 + j; float x = 0.f; if (s <= t) { x = KT[((g * 64 + (t - s)) * 16 + co) * 16 + ci]; if (s == t && ci == co) x += Dk[g * 16 + co]; } v[j] = x; } }
        else {
#pragma unroll
            for (int j = 0; j < 8; ++j) { const int q = (k8 - 128) * 8 + j, p = q >> 1, ri = q & 1; const float cr = cre[(g * 16 + co) * 64 + p], cm = cim[(g * 16 + co) * 64 + p];
                const f32x2 P = *(const f32x2*)(POW + 2 * ((g * 65 + t + 1) * 64 + p)); v[j] = ri ? -(cr * P.y + cm * P.x) : (cr * P.x - cm * P.y); } }
        v4u o; o.x = pkbf(v[0], v[1]); o.y = pkbf(v[2], v[3]); o.z = pkbf(v[4], v[5]); o.w = pkbf(v[6], v[7]);
        *(v4u*)(TF + (size_t)row * 1152 + k8 * 8) = o; }
    for (int i = gt; i < 4096 * 128; i += NGT) { const int row = i >> 7, k8 = i & 127, g = row >> 8, n_ = row & 255, s = k8 >> 1, ci0 = (k8 & 1) * 8; float v[8];
#pragma unroll
        for (int j = 0; j < 8; ++j) { float x = 0.f; if (n_ < 128) { const int p = n_ >> 1, ri = n_ & 1; const f32x2 P = *(const f32x2*)(POW + 2 * ((g * 65 + (63 - s)) * 64 + p));
                const f32x2 B = *(const f32x2*)(BBAR + 2 * ((g * 64 + p) * 16 + ci0 + j)); x = ri ? (P.x * B.y + P.y * B.x) : (P.x * B.x - P.y * B.y); } v[j] = x; }
        v4u o; o.x = pkbf(v[0], v[1]); o.y = pkbf(v[2], v[3]); o.z = pkbf(v[4], v[5]); o.w = pkbf(v[6], v[7]);
        *(v4u*)(EM + (size_t)row * 1024 + k8 * 8) = o; }
}

__device__ __forceinline__ void ln_phase(const bf16* YB, const float* gam, const float* bet, float* X, bf16* XB, const float* WG, float* GATES, float* RST) {
    const int tid = tidx(), lane = tid & 63, wave = tid >> 6; const int gw = bidx() * 8 + wave, NGW = gdim() * 8;
    f32x4 gg[2][2], bb[2][2];
#pragma unroll
    for (int j = 0; j < 2; ++j)
#pragma unroll
        for (int q = 0; q < 2; ++q) { gg[j][q] = *(const f32x4*)(gam + lane * 8 + 512 * j + 4 * q); bb[j][q] = *(const f32x4*)(bet + lane * 8 + 512 * j + 4 * q); }
    for (int row0 = gw * 4; row0 < MT; row0 += NGW * 4) {
        v4u raw[4][2];
#pragma unroll
        for (int r = 0; r < 4; ++r)
#pragma unroll
            for (int j = 0; j < 2; ++j) raw[r][j] = *(const v4u*)(YB + (size_t)(row0 + r) * DM + lane * 8 + 512 * j);
        __builtin_amdgcn_sched_barrier(0);
#pragma unroll
        for (int r = 0; r < 4; ++r) { const int row = row0 + r; f32x4 v[2][2]; float s = 0.f;
#pragma unroll
            for (int j = 0; j < 2; ++j) { v[j][0] = (f32x4){hlo(raw[r][j].x), hhi(raw[r][j].x), hlo(raw[r][j].y), hhi(raw[r][j].y)}; v[j][1] = (f32x4){hlo(raw[r][j].z), hhi(raw[r][j].z), hlo(raw[r][j].w), hhi(raw[r][j].w)};
                s += ((v[j][0].x + v[j][0].y) + (v[j][0].z + v[j][0].w)) + ((v[j][1].x + v[j][1].y) + (v[j][1].z + v[j][1].w)); }
            const float mean = wave_sum(s) * (1.f / DM); float s2 = 0.f;
#pragma unroll
            for (int j = 0; j < 2; ++j)
#pragma unroll
                for (int q = 0; q < 2; ++q) { v[j][q] = v[j][q] - mean; s2 += (v[j][q].x * v[j][q].x + v[j][q].y * v[j][q].y) + (v[j][q].z * v[j][q].z + v[j][q].w * v[j][q].w); }
            const float rstd = 1.f / sqrtf(wave_sum(s2) * (1.f / DM) + EPS);
            if (lane == 0) *(f32x2*)(RST + 2 * (size_t)row) = (f32x2){mean, rstd};
#pragma unroll
            for (int j = 0; j < 2; ++j) { v[j][0] = v[j][0] * rstd * gg[j][0] + bb[j][0]; v[j][1] = v[j][1] * rstd * gg[j][1] + bb[j][1];
                v4u w; w.x = pkbf(v[j][0].x, v[j][0].y); w.y = pkbf(v[j][0].z, v[j][0].w); w.z = pkbf(v[j][1].x, v[j][1].y); w.w = pkbf(v[j][1].z, v[j][1].w);
                if (XB) *(v4u*)(XB + (size_t)row * DM + lane * 8 + 512 * j) = w; }
            if (X) {
#pragma unroll
                for (int j = 0; j < 2; ++j) { *(f32x4*)(X + (size_t)row * DM + lane * 8 + 512 * j) = v[j][0]; *(f32x4*)(X + (size_t)row * DM + lane * 8 + 512 * j + 4) = v[j][1]; } }
            if (WG) { float mine = 0.f;
#pragma unroll
                for (int gc = 0; gc < 8; ++gc) { float p = 0.f;
#pragma unroll
                    for (int j = 0; j < 2; ++j)
#pragma unroll
                        for (int q = 0; q < 2; ++q) { const f32x4 w = *(const f32x4*)(WG + gc * 1024 + lane * 8 + 512 * j + 4 * q); p += (v[j][q].x * w.x + v[j][q].y * w.y) + (v[j][q].z * w.z + v[j][q].w * w.w); }
                    p = wave_sum(p); if (lane == gc) mine = p; }
                if (lane < 8) GATES[(size_t)row * 8 + lane] = mine; }
        }
    }
}

__device__ __forceinline__ void stat_finalize(const float* SP, float* RST) {
    const int gt = bidx() * 512 + tidx(), NGT = gdim() * 512;
    for (int row = gt; row < MT; row += NGT) { const f32x4* p = (const f32x4*)(SP + (size_t)row * 32); float sm = 0.f, sq = 0.f;
#pragma unroll
        for (int i = 0; i < 8; ++i) { const f32x4 v = p[i]; sm += v.x + v.z; sq += v.y + v.w; }
        const float mean = sm * (1.f / DM), var = fmaxf(sq * (1.f / DM) - mean * mean, 0.f); *(f32x2*)(RST + 2 * (size_t)row) = (f32x2){mean, 1.f / sqrtf(var + EPS)}; }
}

#define EPI_ARGS const f32x4 (&acc)[2][2][4][2], const Unit& u, int wr, int wc, int fr, int fq
#define EPI_IDS() do { const int t_ = tidx(); fr = t_ & 15; fq = (t_ >> 4) & 3; wc = (t_ >> 6) & 3; wr = t_ >> 8; } while (0)
struct LnFold { const float* rst; const float* c1; const float* c2;
    __device__ __forceinline__ f32x4 fix(const f32x4& a, const f32x2& ms, int nrow) const { const f32x4 u = *(const f32x4*)(c1 + nrow), v = *(const f32x4*)(c2 + nrow); return (a - u * ms.x) * ms.y + v; }
    __device__ __forceinline__ void load(int nbase, int row0, f32x4 (&u1)[2][2], f32x4 (&u2)[2][2], f32x2 (&ms)[2][4]) const {
#pragma unroll
        for (int bj = 0; bj < 2; ++bj)
#pragma unroll
            for (int n = 0; n < 2; ++n) { u1[bj][n] = *(const f32x4*)(c1 + nbase + bj * 128 + n * 16); u2[bj][n] = *(const f32x4*)(c2 + nbase + bj * 128 + n * 16); }
#pragma unroll
        for (int ai = 0; ai < 2; ++ai)
#pragma unroll
            for (int m = 0; m < 4; ++m) ms[ai][m] = *(const f32x2*)(rst + 2 * (size_t)(row0 + ai * 128 + m * 16));
    }
    static __device__ __forceinline__ f32x4 app(const f32x4& a, const f32x4& u, const f32x4& v, const f32x2& ms) { return (a - u * ms.x) * ms.y + v; }
};
struct EpiSwiGLU { static constexpr bool PERM = true, AFTER_DRAIN = false; bf16* H; LnFold F;
    __device__ __forceinline__ void operator()(EPI_ARGS) const { EPI_IDS();
        const int row0 = u.pm * 256 + wr * 64 + fr, col0 = u.pn * 128 + wc * 32 + 8 * fq, nb = u.pn * 256 + wc * 32 + 8 * fq;
        f32x4 u1[2][2], u2[2][2]; f32x2 msa[2][4];
#pragma unroll
        for (int bj = 0; bj < 2; ++bj)
#pragma unroll
            for (int n = 0; n < 2; ++n) { u1[bj][n] = *(const f32x4*)(F.c1 + nb + bj * 128 + n * 4); u2[bj][n] = *(const f32x4*)(F.c2 + nb + bj * 128 + n * 4); }
#pragma unroll
        for (int ai = 0; ai < 2; ++ai)
#pragma unroll
            for (int m = 0; m < 4; ++m) msa[ai][m] = *(const f32x2*)(F.rst + 2 * (size_t)(row0 + ai * 128 + m * 16));
#pragma unroll
        for (int ai = 0; ai < 2; ++ai)
#pragma unroll
            for (int m = 0; m < 4; ++m) { const int r = row0 + ai * 128 + m * 16; const f32x2 ms = msa[ai][m]; v4u w;
                { const f32x4 g = LnFold::app(acc[ai][0][m][0], u1[0][0], u2[0][0], ms), up = LnFold::app(acc[ai][1][m][0], u1[1][0], u2[1][0], ms);
                  w.x = pkbf(siluf_(g[0]) * up[0], siluf_(g[1]) * up[1]); w.y = pkbf(siluf_(g[2]) * up[2], siluf_(g[3]) * up[3]); }
                { const f32x4 g = LnFold::app(acc[ai][0][m][1], u1[0][1], u2[0][1], ms), up = LnFold::app(acc[ai][1][m][1], u1[1][1], u2[1][1], ms);
                  w.z = pkbf(siluf_(g[0]) * up[0], siluf_(g[1]) * up[1]); w.w = pkbf(siluf_(g[2]) * up[2], siluf_(g[3]) * up[3]); }
                *(v4u*)(H + (size_t)r * DFF + col0) = w; }
    }
};
struct EpiResid { static constexpr bool PERM = false, AFTER_DRAIN = false; const bf16* Xr; bf16* Y; float s; const float* rst; const float* gam; const float* bet; float* sp;
    __device__ __forceinline__ void operator()(EPI_ARGS) const { EPI_IDS();
        const int row0 = u.pm * 256 + wr * 64 + fr, col0 = u.pn * 256 + wc * 32 + 4 * fq;
        f32x4 gg[2][2], bb[2][2];
#pragma unroll
        for (int bj = 0; bj < 2; ++bj)
#pragma unroll
            for (int n = 0; n < 2; ++n) { gg[bj][n] = *(const f32x4*)(gam + col0 + bj * 128 + n * 16) * ALPHA; bb[bj][n] = *(const f32x4*)(bet + col0 + bj * 128 + n * 16) * ALPHA; }
#pragma unroll
        for (int ai = 0; ai < 2; ++ai) {
            v2u x[4][2][2]; f32x2 ms[4];
#pragma unroll
            for (int m = 0; m < 4; ++m) { const int r = row0 + ai * 128 + m * 16; const size_t off = (size_t)r * DM + col0; ms[m] = *(const f32x2*)(rst + 2 * (size_t)r);
#pragma unroll
                for (int bj = 0; bj < 2; ++bj)
#pragma unroll
                    for (int n = 0; n < 2; ++n) x[m][bj][n] = *(const v2u*)(Xr + off + bj * 128 + n * 16); }
            __builtin_amdgcn_sched_barrier(0);
#pragma unroll
            for (int m = 0; m < 4; ++m) { const int r = row0 + ai * 128 + m * 16; const size_t off = (size_t)r * DM + col0; float sm = 0.f, sq = 0.f;
#pragma unroll
                for (int bj = 0; bj < 2; ++bj)
#pragma unroll
                    for (int n = 0; n < 2; ++n) { const f32x4 xv = (f32x4){hlo(x[m][bj][n].x), hhi(x[m][bj][n].x), hlo(x[m][bj][n].y), hhi(x[m][bj][n].y)};
                        const f32x4 y = ((xv - ms[m].x) * ms[m].y) * gg[bj][n] + bb[bj][n] + acc[ai][bj][m][n] * s; v2u w; w.x = pkh(y[0], y[1]); w.y = pkh(y[2], y[3]);
                        *(v2u*)(Y + off + bj * 128 + n * 16) = w;
                        const float y0 = hlo(w.x), y1 = hhi(w.x), y2 = hlo(w.y), y3 = hhi(w.y); sm += (y0 + y1) + (y2 + y3); sq += (y0 * y0 + y1 * y1) + (y2 * y2 + y3 * y3); }
                sm += __shfl_xor(sm, 16); sm += __shfl_xor(sm, 32); sq += __shfl_xor(sq, 16); sq += __shfl_xor(sq, 32);
                if (fq == 0) *(f32x2*)(sp + ((size_t)r * 16 + u.pn * 4 + wc) * 2) = (f32x2){sm, sq}; }
            __builtin_amdgcn_sched_barrier(0);
        }
    }
};
struct EpiBf16 { static constexpr bool PERM = false, AFTER_DRAIN = false; static constexpr int ld = DM; static constexpr float s = 0.0625f * LOG2E; bf16* O; LnFold F;
    __device__ __forceinline__ void operator()(EPI_ARGS) const { EPI_IDS();
        const int row0 = u.pm * 256 + wr * 64 + fr, col0 = u.pn * 256 + wc * 32 + 4 * fq;
        f32x4 u1[2][2], u2[2][2]; f32x2 msa[2][4]; F.load(col0, row0, u1, u2, msa);
#pragma unroll
        for (int ai = 0; ai < 2; ++ai)
#pragma unroll
            for (int m = 0; m < 4; ++m) { const int r = row0 + ai * 128 + m * 16; bf16* rp = O + (size_t)r * ld + col0; const f32x2 ms = msa[ai][m];
#pragma unroll
                for (int bj = 0; bj < 2; ++bj)
#pragma unroll
                    for (int n = 0; n < 2; ++n) { const f32x4 v = LnFold::app(acc[ai][bj][m][n], u1[bj][n], u2[bj][n], ms) * s; v2u w; w.x = pkbf(v[0], v[1]); w.y = pkbf(v[2], v[3]); *(v2u*)(rp + bj * 128 + n * 16) = w; } }
    }
};
struct EpiProj { static constexpr bool PERM = false, AFTER_DRAIN = false; bf16* P; bf16* VT; bf16* SUX; const float* RC; const float* RS; LnFold F; float* GATES;
    __device__ __forceinline__ void operator()(EPI_ARGS) const { EPI_IDS();
        const int row0 = u.pm * 256 + wr * 64 + fr; const int pn = u.pn;
        f32x4 u1[2][2], u2[2][2]; f32x2 msa[2][4]; F.load(pn * 256 + wc * 32 + 4 * fq, row0, u1, u2, msa);
        if (pn < 4) { const float sc = pn < 2 ? 0.125f * LOG2E : 1.f;
#pragma unroll
            for (int ai = 0; ai < 2; ++ai)
#pragma unroll
                for (int m = 0; m < 4; ++m) { const int r = row0 + ai * 128 + m * 16, pos = r & 4095; bf16* rp = P + (size_t)r * NPJ + pn * 256 + wc * 64 + 4 * fq; const f32x2 ms = msa[ai][m];
#pragma unroll
                    for (int n = 0; n < 2; ++n) { const f32x4 c = *(const f32x4*)(RC + pos * 32 + n * 16 + 4 * fq), s = *(const f32x4*)(RS + pos * 32 + n * 16 + 4 * fq);
                        const f32x4 t1 = LnFold::app(acc[ai][0][m][n], u1[0][n], u2[0][n], ms), t2 = LnFold::app(acc[ai][1][m][n], u1[1][n], u2[1][n], ms); const f32x4 o1 = (t1 * c - t2 * s) * sc, o2 = (t2 * c + t1 * s) * sc; v2u w;
                        w.x = pkbf(o1[0], o1[1]); w.y = pkbf(o1[2], o1[3]); *(v2u*)(rp + n * 16) = w; w.x = pkbf(o2[0], o2[1]); w.y = pkbf(o2[2], o2[3]); *(v2u*)(rp + 32 + n * 16) = w; } }
        } else if (pn < 6) {
#pragma unroll
            for (int ai = 0; ai < 2; ++ai)
#pragma unroll
                for (int m = 0; m < 4; ++m) { const int r = row0 + ai * 128 + m * 16, b = r >> 12, sp = r & 4095; const f32x2 ms = msa[ai][m];
#pragma unroll
                    for (int bj = 0; bj < 2; ++bj) { const int h = 2 * (pn - 4) + bj; bf16* vp = VT + ((size_t)((b * 4 + h) * 128 + wc * 32 + 4 * fq)) * 4096 + sp;
#pragma unroll
                        for (int n = 0; n < 2; ++n) { const f32x4 v = LnFold::app(acc[ai][bj][m][n], u1[bj][n], u2[bj][n], ms); const unsigned w0 = pkbf(v[0], v[1]), w1 = pkbf(v[2], v[3]);
                            vp[(size_t)(n * 16 + 0) * 4096] = (bf16)(w0 & 0xffff); vp[(size_t)(n * 16 + 1) * 4096] = (bf16)(w0 >> 16);
                            vp[(size_t)(n * 16 + 2) * 4096] = (bf16)(w1 & 0xffff); vp[(size_t)(n * 16 + 3) * 4096] = (bf16)(w1 >> 16); } } }
        } else if (pn < 10) {
#pragma unroll
            for (int ai = 0; ai < 2; ++ai)
#pragma unroll
                for (int m = 0; m < 4; ++m) { const int r = row0 + ai * 128 + m * 16; bf16* rp = P + (size_t)r * NPJ + pn * 256 + wc * 32 + 4 * fq; const f32x2 ms = msa[ai][m];
#pragma unroll
                    for (int bj = 0; bj < 2; ++bj)
#pragma unroll
                        for (int n = 0; n < 2; ++n) { const f32x4 v = LnFold::app(acc[ai][bj][m][n], u1[bj][n], u2[bj][n], ms); v2u w; w.x = pkbf(v[0], v[1]); w.y = pkbf(v[2], v[3]); *(v2u*)(rp + bj * 128 + n * 16) = w; } }
        } else if (pn == 11) {
            if (wc == 0 && fq < 2) {
#pragma unroll
                for (int ai = 0; ai < 2; ++ai)
#pragma unroll
                    for (int m = 0; m < 4; ++m) { const int r = row0 + ai * 128 + m * 16; const f32x2 ms = msa[ai][m];
                        *(f32x4*)(GATES + (size_t)r * 8 + 4 * fq) = LnFold::app(acc[ai][0][m][0], u1[0][0], u2[0][0], ms); } }
        } else {
#pragma unroll
            for (int ai = 0; ai < 2; ++ai)
#pragma unroll
                for (int m = 0; m < 4; ++m) { const int r = row0 + ai * 128 + m * 16, mch = r >> 6, t = r & 63; const f32x2 ms = msa[ai][m];
#pragma unroll
                    for (int bj = 0; bj < 2; ++bj)
#pragma unroll
                        for (int n = 0; n < 2; ++n) { const int g = 8 * bj + 2 * wc + n; const f32x4 v = LnFold::app(acc[ai][bj][m][n], u1[bj][n], u2[bj][n], ms); v2u w; w.x = pkbf(v[0], v[1]); w.y = pkbf(v[2], v[3]);
                            *(v2u*)(SUX + ((size_t)g * 1024 + mch) * 1152 + t * 16 + 4 * fq) = w; } }
        }
    }
};
struct EpiKV { static constexpr bool PERM = false, AFTER_DRAIN = false; bf16* KX; bf16* VTX;
    __device__ __forceinline__ void operator()(EPI_ARGS) const { EPI_IDS();
        const int row0 = u.pm * 256 + wr * 64 + fr; const int pn = u.pn;
        if (pn < 4) {
#pragma unroll
            for (int ai = 0; ai < 2; ++ai)
#pragma unroll
                for (int m = 0; m < 4; ++m) { bf16* rp = KX + (size_t)(row0 + ai * 128 + m * 16) * 1024 + pn * 256 + wc * 32 + 4 * fq;
#pragma unroll
                    for (int bj = 0; bj < 2; ++bj)
#pragma unroll
                        for (int n = 0; n < 2; ++n) { const f32x4 v = acc[ai][bj][m][n]; v2u w; w.x = pkbf(v[0], v[1]); w.y = pkbf(v[2], v[3]); *(v2u*)(rp + bj * 128 + n * 16) = w; } }
        } else { const int h = pn - 4;
#pragma unroll
            for (int ai = 0; ai < 2; ++ai)
#pragma unroll
                for (int m = 0; m < 4; ++m) { const int r = row0 + ai * 128 + m * 16, b = r >> 8, sp = r & 255;
#pragma unroll
                    for (int bj = 0; bj < 2; ++bj) { bf16* vp = VTX + ((size_t)((b * 4 + h) * 256 + bj * 128 + wc * 32 + 4 * fq)) * 256 + sp;
#pragma unroll
                        for (int n = 0; n < 2; ++n) { const f32x4 v = acc[ai][bj][m][n]; const unsigned w0 = pkbf(v[0], v[1]), w1 = pkbf(v[2], v[3]);
                            vp[(n * 16 + 0) * 256] = (bf16)(w0 & 0xffff); vp[(n * 16 + 1) * 256] = (bf16)(w0 >> 16);
                            vp[(n * 16 + 2) * 256] = (bf16)(w1 & 0xffff); vp[(n * 16 + 3) * 256] = (bf16)(w1 >> 16); } } }
        }
    }
};
struct EpiS5E { static constexpr bool PERM = false, AFTER_DRAIN = false; float* E;
    __device__ __forceinline__ void operator()(EPI_ARGS) const { EPI_IDS();
        const int row0 = u.pm * 256 + wr * 64 + fr;
#pragma unroll
        for (int ai = 0; ai < 2; ++ai)
#pragma unroll
            for (int m = 0; m < 4; ++m) { float* rp = E + (size_t)(row0 + ai * 128 + m * 16) * 128 + wc * 32 + 4 * fq;
#pragma unroll
                for (int n = 0; n < 2; ++n) *(f32x4*)(rp + n * 16) = acc[ai][0][m][n]; }
    }
};
struct EpiS5Y { static constexpr bool PERM = false, AFTER_DRAIN = false; bf16* Yo;
    __device__ __forceinline__ void operator()(EPI_ARGS) const { EPI_IDS();
        const int row0 = u.pm * 256 + wr * 64 + fr; const int pnl = u.pn & 3;
#pragma unroll
        for (int ai = 0; ai < 2; ++ai)
#pragma unroll
            for (int m = 0; m < 4; ++m) { const int R = row0 + ai * 128 + m * 16, g = R >> 10, mch = R & 1023;
#pragma unroll
                for (int bj = 0; bj < 2; ++bj)
#pragma unroll
                    for (int n = 0; n < 2; ++n) { const int t = pnl * 16 + bj * 8 + wc * 2 + n; const f32x4 v = acc[ai][bj][m][n]; v2u w;
                        w.x = pkbf(gelu_tanh(v[0]), gelu_tanh(v[1])); w.y = pkbf(gelu_tanh(v[2]), gelu_tanh(v[3]));
                        *(v2u*)(Yo + ((size_t)mch * 64 + t) * 256 + g * 16 + 4 * fq) = w; asm volatile("" ::: "memory"); } }
    }
};
struct EpiGLU { static constexpr bool PERM = false, AFTER_DRAIN = false; const bf16* Ys; const float* gb; bf16* CAT;
    __device__ __forceinline__ void operator()(EPI_ARGS) const { EPI_IDS();
        const int row0 = u.pm * 256 + wr * 64 + fr, col0 = wc * 32 + 4 * fq;
#pragma unroll
        for (int ai = 0; ai < 2; ++ai)
#pragma unroll
            for (int m = 0; m < 4; ++m) { const size_t r = (size_t)(row0 + ai * 128 + m * 16);
#pragma unroll
                for (int bj = 0; bj < 2; ++bj)
#pragma unroll
                    for (int n = 0; n < 2; ++n) { const int c = col0 + bj * 128 + n * 16; const f32x4 b = *(const f32x4*)(gb + c); const v2u yw = *(const v2u*)(Ys + r * 256 + c);
                        const f32x4 v = acc[ai][bj][m][n] + b; v2u w;
                        w.x = pkbf(bflo(yw.x) * sigmoidf_(v[0]), bfhi(yw.x) * sigmoidf_(v[1])); w.y = pkbf(bflo(yw.y) * sigmoidf_(v[2]), bfhi(yw.y) * sigmoidf_(v[3]));
                        *(v2u*)(CAT + r * DM + 768 + c) = w; asm volatile("" ::: "memory"); } }
    }
};
struct GroupOrder { int nwg, G, c, npm, npn;
    __device__ __forceinline__ void init(int ngroups, int npm_, int npn_, int G_, int c_) { npm = npm_; npn = npn_; nwg = ngroups * npm_ * npn_; G = G_; c = c_; }
    __device__ __forceinline__ bool next(int i, Unit& u) const { const int L = i * G + c; if (L >= nwg) return false; const int per = npm * npn, g = L / per, r = L % per; u.pm = g * npm + r % npm; u.pn = g * npn + r / npm; return true; }
    __device__ __forceinline__ void a_ready(const Unit&) const {}
    __device__ __forceinline__ void done(const Unit&) const {}
};
template <class Epi, bool F16 = false> __device__ __forceinline__ void run_gemm(LAS unsigned char* lds, const bf16* Ap, const bf16* Bt, int M, int N, int K, int lda, int ldb, const Epi& E) {
    pg8::Gemm g{Ap, Bt, M, N, K, lda, ldb}; pg8::StaticOrder S; S.init(M, N, gdim(), bidx());
    pg8::gemm_phase<Epi, pg8::StaticOrder, true, true, F16>(lds, g, S, E);
}

__device__ __forceinline__ float qmax4(float m) {
    auto r = __builtin_amdgcn_permlane32_swap(__float_as_uint(m), __float_as_uint(m), false, false); m = fmaxf(__uint_as_float(r[0]), __uint_as_float(r[1]));
    auto q = __builtin_amdgcn_permlane16_swap(__float_as_uint(m), __float_as_uint(m), false, false); return fmaxf(__uint_as_float(q[0]), __uint_as_float(q[1]));
}
template <int NMAP, int DQK, int DV>
__device__ __forceinline__ void attn_qks(LAS unsigned char* cur, int qi, int g, const bf16x8 (&qf)[NMAP][DQK / 32], f32x4 (&O)[NMAP][DV / 16], float (&lsum)[NMAP], float (&mrun)[NMAP], bf16x8 (&pf)[NMAP][2]) {
    constexpr int KPL = NMAP * 64 * 16, VPL = DV * 16, VS_OFF = NMAP * 64 * DQK * 2, NKS = DQK / 32;
    float al[NMAP]; bool resc = false;
#pragma unroll
    for (int mp = 0; mp < NMAP; ++mp) {
        f32x4 s[4];
        {
            bf16x8 kf[2][NKS];
#pragma unroll
            for (int ks = 0; ks < NKS; ++ks) kf[0][ks] = *(const LAS bf16x8*)(cur + (ks * 4 + g) * KPL + (mp * 64 + qi) * 16);
#pragma unroll
            for (int jb = 0; jb < 4; ++jb) { s[jb] = (f32x4){0.f, 0.f, 0.f, 0.f};
                if (jb < 3) {
#pragma unroll
                    for (int ks = 0; ks < NKS; ++ks) kf[(jb + 1) & 1][ks] = *(const LAS bf16x8*)(cur + (ks * 4 + g) * KPL + (mp * 64 + 16 * (jb + 1) + qi) * 16); }
                __builtin_amdgcn_sched_barrier(0);
#pragma unroll
                for (int ks = 0; ks < NKS; ++ks) s[jb] = __builtin_amdgcn_mfma_f32_16x16x32_bf16(kf[jb & 1][ks], qf[mp][ks], s[jb], 0, 0, 0);
                __builtin_amdgcn_sched_barrier(0); }
        }
        float mx = fmaxf(fmaxf(fmaxf(s[0][0], s[0][1]), fmaxf(s[0][2], s[0][3])), fmaxf(fmaxf(s[1][0], s[1][1]), fmaxf(s[1][2], s[1][3])));
        mx = fmaxf(mx, fmaxf(fmaxf(fmaxf(s[2][0], s[2][1]), fmaxf(s[2][2], s[2][3])), fmaxf(fmaxf(s[3][0], s[3][1]), fmaxf(s[3][2], s[3][3]))));
        mx = qmax4(mx);
        const bool upd = (mx - mrun[mp]) > 8.f; const float mnew = upd ? mx : mrun[mp]; al[mp] = upd ? __builtin_amdgcn_exp2f(mrun[mp] - mnew) : 1.f; resc = resc || upd; mrun[mp] = mnew;
        float ps = 0.f;
#pragma unroll
        for (int jb = 0; jb < 4; ++jb)
#pragma unroll
            for (int r = 0; r < 4; ++r) { s[jb][r] = __builtin_amdgcn_exp2f(s[jb][r] - mnew); ps += s[jb][r]; }
        lsum[mp] = lsum[mp] * al[mp] + ps;
#pragma unroll
        for (int tg = 0; tg < 2; ++tg) { v4u pw; pw.x = pkbf(s[2 * tg][0], s[2 * tg][1]); pw.y = pkbf(s[2 * tg][2], s[2 * tg][3]); pw.z = pkbf(s[2 * tg + 1][0], s[2 * tg + 1][1]); pw.w = pkbf(s[2 * tg + 1][2], s[2 * tg + 1][3]);
            pf[mp][tg] = __builtin_bit_cast(bf16x8, pw); }
    }
    if (__any(resc)) {
#pragma unroll
        for (int mp = 0; mp < NMAP; ++mp)
#pragma unroll
            for (int db = 0; db < DV / 16; ++db) O[mp][db] = O[mp][db] * al[mp];
    }
}
template <int NMAP, int DQK, int DV, int VBN_ = 0>
__device__ __forceinline__ void attn_pv(LAS unsigned char* cur, int qi, int g, const bf16x8 (&pf)[NMAP][2], f32x4 (&O)[NMAP][DV / 16]) {
    constexpr int VPL = DV * 16, VS_OFF = NMAP * 64 * DQK * 2;
    {
        constexpr int NDB = DV / 16, VBN = VBN_ ? VBN_ : ((DV > 128) ? 4 : 8), NBT = 2 * NDB / VBN;
        bf16x8 vf[2][VBN];
#pragma unroll
        for (int i = 0; i < VBN; ++i) vf[0][i] = *(const LAS bf16x8*)(cur + VS_OFF + g * VPL + (i * 16 + qi) * 16);
#pragma unroll
        for (int bt = 0; bt < NBT; ++bt) {
            if (bt + 1 < NBT) {
#pragma unroll
                for (int i = 0; i < VBN; ++i) { const int f = (bt + 1) * VBN + i, tg = f / NDB, db = f % NDB; vf[(bt + 1) & 1][i] = *(const LAS bf16x8*)(cur + VS_OFF + (tg * 4 + g) * VPL + (db * 16 + qi) * 16); } }
            __builtin_amdgcn_sched_barrier(0);
#pragma unroll
            for (int i = 0; i < VBN; ++i) { const int f = bt * VBN + i, tg = f / NDB, db = f % NDB;
#pragma unroll
                for (int mp = 0; mp < NMAP; ++mp) O[mp][db] = __builtin_amdgcn_mfma_f32_16x16x32_bf16(vf[bt & 1][i], pf[mp][tg], O[mp][db], 0, 0, 0); }
            __builtin_amdgcn_sched_barrier(0);
        }
    }
}
template <int NMAP, int DQK, int DV>
__device__ __forceinline__ void attn_tile(LAS unsigned char* cur, int qi, int g, const bf16x8 (&qf)[NMAP][DQK / 32], f32x4 (&O)[NMAP][DV / 16], float (&lsum)[NMAP], float (&mrun)[NMAP]) {
    bf16x8 pf[NMAP][2]; attn_qks<NMAP, DQK, DV>(cur, qi, g, qf, O, lsum, mrun, pf); attn_pv<NMAP, DQK, DV>(cur, qi, g, pf, O);
}
template <int NMAP, int DQK, int DV, bool DBUF>
__device__ __forceinline__ void attn_core(LAS unsigned char* lds, const bf16* Q, int qpitch, const bf16* K, int kpitch, const bf16* VT, int vpitch,
                                          int NT, int my_nt, f32x4 (&O)[NMAP][DV / 16], float (&lsum)[NMAP]) {
    constexpr int CPR = DQK / 8, KCH = NMAP * 64 * CPR / 512, VCH = DV * 8 / 512, KPL = NMAP * 64 * 16, VPL = DV * 16, VS_OFF = NMAP * 64 * DQK * 2, NKS = DQK / 32, NRG = NMAP * 8;
    constexpr int BUFB = VS_OFF + DV * 128;
    const int tid = tidx(), lane = tid & 63, qi = lane & 15, g = lane >> 4;
    bf16x8 qf[NMAP][NKS];
#pragma unroll
    for (int mp = 0; mp < NMAP; ++mp)
#pragma unroll
        for (int ks = 0; ks < NKS; ++ks) qf[mp][ks] = *(const bf16x8*)(Q + (size_t)qi * qpitch + mp * DQK + ks * 32 + g * 8);
    float mrun[NMAP];
#pragma unroll
    for (int mp = 0; mp < NMAP; ++mp) { mrun[mp] = -INFINITY; lsum[mp] = 0.f;
#pragma unroll
        for (int db = 0; db < DV / 16; ++db) O[mp][db] = (f32x4){0.f, 0.f, 0.f, 0.f}; }
    v4u kregA[KCH], vregA[VCH], kregB[DBUF ? KCH : 1], vregB[DBUF ? VCH : 1];
#define ATT_LOAD(t, KR, VR) do { _Pragma("unroll") for (int i = 0; i < KCH; ++i) { const int w64 = (tid >> 6) + i * 8, prow = (w64 % NRG) * 8 + (lane & 7), ch = (w64 / NRG) * 8 + (lane >> 3), p6 = prow & 63; \
            const int kv = (p6 & 32) + 8 * ((p6 >> 2) & 3) + 4 * ((p6 >> 4) & 1) + (p6 & 3); \
            KR[i] = *(const v4u*)(K + (size_t)((t) * 64 + kv) * kpitch + (prow >> 6) * DQK + ch * 8); } \
        _Pragma("unroll") for (int i = 0; i < VCH; ++i) { const int w64 = (tid >> 6) + i * 8, d = w64 * 8 + (lane & 7), ch = lane >> 3; \
            VR[i] = *(const v4u*)(VT + (size_t)d * vpitch + (t) * 64 + ch * 8); } } while (0)
#define ATT_STORE(B, KR, VR) do { _Pragma("unroll") for (int i = 0; i < KCH; ++i) { const int w64 = (tid >> 6) + i * 8, prow = (w64 % NRG) * 8 + (lane & 7), ch = (w64 / NRG) * 8 + (lane >> 3); *(LAS v4u*)((B) + ch * KPL + prow * 16) = KR[i]; } \
        _Pragma("unroll") for (int i = 0; i < VCH; ++i) { const int w64 = (tid >> 6) + i * 8, d = w64 * 8 + (lane & 7), ch = lane >> 3; *(LAS v4u*)((B) + VS_OFF + ch * VPL + d * 16) = VR[i]; } } while (0)
    if (DBUF) {
        ATT_LOAD(0, kregA, vregA);
        __syncthreads(); ATT_STORE(lds, kregA, vregA);
        ATT_LOAD(1, kregA, vregA); if (NT > 2) ATT_LOAD(2, kregB, vregB);
        __syncthreads();
        for (int t = 0; t < NT; t += 2) {
            ATT_STORE(lds + BUFB, kregA, vregA); if (t + 3 < NT) ATT_LOAD(t + 3, kregA, vregA);
            if (t < my_nt) attn_tile<NMAP, DQK, DV>(lds, qi, g, qf, O, lsum, mrun);
            __syncthreads();
            if (t + 2 < NT) { ATT_STORE(lds, kregB, vregB); if (t + 4 < NT) ATT_LOAD(t + 4, kregB, vregB); }
            if (t + 1 < my_nt) attn_tile<NMAP, DQK, DV>(lds + BUFB, qi, g, qf, O, lsum, mrun);
            __syncthreads();
        }
    } else {
        ATT_LOAD(0, kregA, vregA);
        for (int t = 0; t < NT; ++t) {
            __syncthreads(); ATT_STORE(lds, kregA, vregA); __syncthreads(); if (t + 1 < NT) ATT_LOAD(t + 1, kregA, vregA);
            if (t < my_nt) attn_tile<NMAP, DQK, DV>(lds, qi, g, qf, O, lsum, mrun);
        }
    }
#undef ATT_LOAD
#undef ATT_STORE
#pragma unroll
    for (int mp = 0; mp < NMAP; ++mp) { lsum[mp] += __shfl_xor(lsum[mp], 16); lsum[mp] += __shfl_xor(lsum[mp], 32); }
}

__device__ __forceinline__ void diff_core_skew(LAS unsigned char* lds, const bf16* Q, int qpitch, const bf16* K, int kpitch, const bf16* VT, int vpitch,
                                               int NT, int my_nt, bool lag, f32x4 (&O)[2][8], float (&lsum)[2]) {
    constexpr int NMAP = 2, DQK = 64, DV = 128, CPR = 8, KCH = 2, VCH = 2, KPL = NMAP * 64 * 16, VPL = DV * 16, VS_OFF = NMAP * 64 * DQK * 2, NRG = NMAP * 8, BUFB = VS_OFF + DV * 128;
    const int tid = tidx(), lane = tid & 63, qi = lane & 15, g = lane >> 4;
    bf16x8 qf[2][2];
#pragma unroll
    for (int mp = 0; mp < 2; ++mp)
#pragma unroll
        for (int ks = 0; ks < 2; ++ks) qf[mp][ks] = *(const bf16x8*)(Q + (size_t)qi * qpitch + mp * DQK + ks * 32 + g * 8);
    float mrun[2] = {-INFINITY, -INFINITY}; lsum[0] = 0.f; lsum[1] = 0.f;
#pragma unroll
    for (int mp = 0; mp < 2; ++mp)
#pragma unroll
        for (int db = 0; db < 8; ++db) O[mp][db] = (f32x4){0.f, 0.f, 0.f, 0.f};
    v4u kregA[KCH], vregA[VCH], kregB[KCH], vregB[VCH];
#define SK_LOAD(t, KR, VR) do { _Pragma("unroll") for (int i = 0; i < KCH; ++i) { const int w64 = (tid >> 6) + i * 8, prow = (w64 % NRG) * 8 + (lane & 7), ch = (w64 / NRG) * 8 + (lane >> 3), p6 = prow & 63; \
            const int kv = (p6 & 32) + 8 * ((p6 >> 2) & 3) + 4 * ((p6 >> 4) & 1) + (p6 & 3); \
            KR[i] = *(const v4u*)(K + (size_t)((t) * 64 + kv) * kpitch + (prow >> 6) * DQK + ch * 8); } \
        _Pragma("unroll") for (int i = 0; i < VCH; ++i) { const int w64 = (tid >> 6) + i * 8, d = w64 * 8 + (lane & 7), ch = lane >> 3; \
            VR[i] = *(const v4u*)(VT + (size_t)d * vpitch + (t) * 64 + ch * 8); } } while (0)
#define SK_STORE(B, KR, VR) do { _Pragma("unroll") for (int i = 0; i < KCH; ++i) { const int w64 = (tid >> 6) + i * 8, prow = (w64 % NRG) * 8 + (lane & 7), ch = (w64 / NRG) * 8 + (lane >> 3); *(LAS v4u*)((B) + ch * KPL + prow * 16) = KR[i]; } \
        _Pragma("unroll") for (int i = 0; i < VCH; ++i) { const int w64 = (tid >> 6) + i * 8, d = w64 * 8 + (lane & 7), ch = lane >> 3; *(LAS v4u*)((B) + VS_OFF + ch * VPL + d * 16) = VR[i]; } } while (0)
    bf16x8 pfp[2][2];
#pragma unroll
    for (int mp = 0; mp < 2; ++mp) { pfp[mp][0] = (bf16x8){0, 0, 0, 0, 0, 0, 0, 0}; pfp[mp][1] = pfp[mp][0]; }
#define SK_STEP(t, ic, ip, in_) do { \
        if (!lag) { if ((t) < my_nt) { bf16x8 pf_[2][2]; attn_qks<2, 64, 128>(lds + (ic) * BUFB, qi, g, qf, O, lsum, mrun, pf_); attn_pv<2, 64, 128, 4>(lds + (ic) * BUFB, qi, g, pf_, O); } } \
        else { if ((t) >= 1 && (t) - 1 < my_nt) attn_pv<2, 64, 128, 4>(lds + (ip) * BUFB, qi, g, pfp, O); \
               if ((t) < my_nt) attn_qks<2, 64, 128>(lds + (ic) * BUFB, qi, g, qf, O, lsum, mrun, pfp); } } while (0)
    SK_LOAD(0, kregA, vregA); SK_LOAD(1, kregB, vregB);
    __syncthreads(); SK_STORE(lds, kregA, vregA);
    if (NT > 2) SK_LOAD(2, kregA, vregA);
    __syncthreads();
    int ic = 0, ip = 2, in_ = 1;
    for (int t = 0; t < NT; t += 2) {
        SK_STORE(lds + in_ * BUFB, kregB, vregB); if (t + 3 < NT) SK_LOAD(t + 3, kregB, vregB);
        SK_STEP(t, ic, ip, in_);
        __syncthreads();
        ip = ic; ic = in_; in_ = in_ == 2 ? 0 : in_ + 1;
        if (t + 2 < NT) { SK_STORE(lds + in_ * BUFB, kregA, vregA); if (t + 4 < NT) SK_LOAD(t + 4, kregA, vregA); }
        SK_STEP(t + 1, ic, ip, in_);
        __syncthreads();
        ip = ic; ic = in_; in_ = in_ == 2 ? 0 : in_ + 1;
    }
    if (lag && NT - 1 < my_nt) attn_pv<2, 64, 128, 4>(lds + ip * BUFB, qi, g, pfp, O);
#undef SK_LOAD
#undef SK_STORE
#undef SK_STEP
    lsum[0] += __shfl_xor(lsum[0], 16); lsum[0] += __shfl_xor(lsum[0], 32); lsum[1] += __shfl_xor(lsum[1], 16); lsum[1] += __shfl_xor(lsum[1], 32);
}
__device__ __forceinline__ void diffattn_phase(CArgs& A, LAS unsigned char* lds, int l) {
    l = lnd(l);
    const int tid = tidx(), lane = tid & 63, wave = tid >> 6, qi = lane & 15, g = lane >> 4;
    const bf16* P = (const bf16*)(A.ws + WS_HP); const bf16* VT = (const bf16*)((unsigned char*)A.out + OUT_VT); bf16* CAT = (bf16*)(A.ws + WS_CAT);
    const float lambda_init = 0.8f - 0.6f * expf(-0.3f * (float)l);
    float lam; { const float* dl = A.in[12] + l * 256; float a = 0.f, b2 = 0.f; for (int i = 0; i < 64; ++i) { a += dl[i] * dl[64 + i]; b2 += dl[128 + i] * dl[192 + i]; } lam = expf(a) - expf(b2) + lambda_init; }
    const float* gn = A.in[13] + l * 128;
    const int nblk = gdim(), bid = bidx(); const bool xcd_ok = (nblk == 256);
    for (int it = 0, pi0 = bid; pi0 < 1024; pi0 += nblk, ++it) {
        int pi = pi0; if (xcd_ok) { const int xcd = bid & 7, j = bid >> 3; pi = ((xcd * 8 + it * 2 + (j >> 4)) << 4) | (j & 15); }
        const int bh = pi >> 4, s = pi & 15, b = bh >> 2, h = bh & 3;
        for (int half = 0; half < 2; ++half) {
            const int qblk = half ? 31 - s : s, NT = 2 * qblk + 2, my_nt = 2 * qblk + (wave >> 2) + 1;
            const size_t row0 = (size_t)b * 4096 + qblk * 128 + wave * 16;
            f32x4 O[2][8]; float ls[2];
            diff_core_skew(lds, P + row0 * NPJ + h * 128, NPJ, P + (size_t)b * 4096 * NPJ + 512 + h * 128, NPJ, VT + (size_t)((b * 4 + h) * 128) * 4096, 4096, NT, my_nt, wave >= 4, O, ls);
            const float i1 = 1.f / ls[0], i2 = lam / ls[1]; float ss = 0.f;
#pragma unroll
            for (int db = 0; db < 8; ++db) { O[0][db] = O[0][db] * i1 - O[1][db] * i2; ss += (O[0][db][0] * O[0][db][0] + O[0][db][1] * O[0][db][1]) + (O[0][db][2] * O[0][db][2] + O[0][db][3] * O[0][db][3]); }
            ss += __shfl_xor(ss, 16); ss += __shfl_xor(ss, 32);
            const float rs = (1.f - lambda_init) / sqrtf(ss * (1.f / 128.f) + EPS);
            bf16* op = CAT + (row0 + qi) * DM + h * 128 + 4 * g;
#pragma unroll
            for (int db = 0; db < 8; ++db) { const f32x4 gg = *(const f32x4*)(gn + db * 16 + 4 * g); const f32x4 v = O[0][db] * rs * gg; v2u w; w.x = pkbf(v[0], v[1]); w.y = pkbf(v[2], v[3]); *(v2u*)(op + db * 16) = w; }
        }
    }
    __syncthreads();
}
__device__ __forceinline__ void xattn_phase(CArgs& A, LAS unsigned char* lds) {
    const int tid = tidx(), lane = tid & 63, wave = tid >> 6, qi = lane & 15, g = lane >> 4;
    const bf16* QX = (const bf16*)(A.ws + WS_HP); bf16* OX = (bf16*)(A.ws + WS_HP + 128 * MiB); const bf16* KX = (const bf16*)(A.ws + WS_KX); const bf16* VTX = (const bf16*)(A.ws + WS_VTX);
    for (int u = bidx(); u < 2048; u += gdim()) {
        const int b = u >> 7, h = (u >> 5) & 3, qblk = u & 31; const size_t row0 = (size_t)b * 4096 + qblk * 128 + wave * 16;
        f32x4 O[1][16]; float ls[1];
        attn_core<1, 256, 256, false>(lds, QX + row0 * DM + h * 256, DM, KX + (size_t)b * 256 * DM + h * 256, DM, VTX + (size_t)((b * 4 + h) * 256) * 256, 256, 4, 4, O, ls);
        const float il = 1.f / ls[0]; LAS unsigned char* stg = lds + 65536 + wave * 8448;
#pragma unroll
        for (int db = 0; db < 16; ++db) { const f32x4 v = O[0][db] * il; v2u w; w.x = pkbf(v[0], v[1]); w.y = pkbf(v[2], v[3]); *(LAS v2u*)(stg + qi * 528 + (16 * db + 4 * g) * 2) = w; }
        asm volatile("s_waitcnt lgkmcnt(0)" ::: "memory");
#pragma unroll
        for (int i = 0; i < 8; ++i) { const int idx = i * 64 + lane, row = idx >> 5, ch = idx & 31; const v4u v = *(const LAS v4u*)(stg + row * 528 + ch * 16);
            *(v4u*)(OX + (row0 + row) * DM + h * 256 + ch * 8) = v; }
        asm volatile("s_waitcnt lgkmcnt(0)" ::: "memory");
    }
    __syncthreads();
}

__device__ __forceinline__ void conv8(CArgs& A, int l, const bf16* P, int b, int pos, int col, int cch, float (&o)[8]) {
    const float* cw = A.in[8] + l * 2048; const float* cb = A.in[9] + l * 512;
#pragma unroll
    for (int e = 0; e < 8; ++e) o[e] = cb[cch + e];
#pragma unroll
    for (int j = 0; j < 4; ++j) { const int pj = pos - 3 + j; if (pj >= 0) { const v4u x = *(const v4u*)(P + ((size_t)b * 4096 + pj) * NPJ + col); const float* w = cw + j * 512 + cch;
            o[0] += w[0] * bflo(x.x); o[1] += w[1] * bfhi(x.x); o[2] += w[2] * bflo(x.y); o[3] += w[3] * bfhi(x.y); o[4] += w[4] * bflo(x.z); o[5] += w[5] * bfhi(x.z); o[6] += w[6] * bflo(x.w); o[7] += w[7] * bfhi(x.w); } }
#pragma unroll
    for (int e = 0; e < 8; ++e) o[e] = siluf_(o[e]);
}
__device__ __forceinline__ float logsigmoidf_(float x) { return fminf(x, 0.f) - log1pf(__expf(-fabsf(x))); }
constexpr int ML_Q = 0, ML_KT = 4160, ML_V = 8256, ML_P = 12352, ML_CT = 16512, ML_MISC = 20608;
__device__ __forceinline__ void mlstm_local(CArgs& A, LAS unsigned char* lds, int l) {
    l = lnd(l);
    const int tid = tidx(), lane = tid & 63, wave = tid >> 6, half = wave >> 2, hw = wave & 3, ht = tid & 255, qi = lane & 15, g = lane >> 4;
    constexpr int PT = 72, HB = 20480;
    LAS unsigned char* hb = lds + half * HB; LAS float* wt = (LAS float*)(hb + 18432);
    const bf16* P = (const bf16*)(A.ws + WS_HP); const float* GT = (const float*)(A.ws + WS_GATES); const float* gb = A.in[10] + l * 8;
    float* Cb = (float*)((unsigned char*)A.out + OUT_C); float* Nb = (float*)(A.ws + WS_NST); float* AB = (float*)(A.ws + WS_AB);
    const int nblk_ = gdim(), bid_ = bidx(); const bool deal = nblk_ == 256;
    const int np_ = deal ? (bid_ < 64 ? 5 : 9) : (2048 - bid_ + nblk_ - 1) / nblk_, p0_ = deal ? (bid_ < 64 ? bid_ * 5 : 320 + (bid_ - 64) * 9) : bid_, ps_ = deal ? 1 : nblk_;
    for (int ip_ = 0; ip_ < np_; ++ip_) { const int u0 = 2 * (p0_ + ip_ * ps_);
        const int u = u0 + half, bh = u >> 6, c = u & 63, b = bh >> 2, h = bh & 3; const int s = ht >> 2, d16 = (ht & 3) * 16, pos = c * 64 + s;
        const size_t prow = ((size_t)b * 4096 + pos) * NPJ;
        const v4u x0 = *(const v4u*)(P + prow + 2048 + h * 64 + d16), x1 = *(const v4u*)(P + prow + 2048 + h * 64 + d16 + 8);
        { float k0[8], k1[8]; conv8(A, l, P, b, pos, 1792 + h * 64 + d16, 256 + h * 64 + d16, k0); conv8(A, l, P, b, pos, 1792 + h * 64 + d16 + 8, 256 + h * 64 + d16 + 8, k1);
          LAS bf16* kt = (LAS bf16*)(hb + 9216) + d16 * PT + s;
#pragma unroll
          for (int e = 0; e < 8; e += 2) { const unsigned w0 = pkbf(k0[e] * 0.125f, k0[e + 1] * 0.125f), w1 = pkbf(k1[e] * 0.125f, k1[e + 1] * 0.125f);
              kt[e * PT] = (bf16)(w0 & 0xffff); kt[(e + 1) * PT] = (bf16)(w0 >> 16); kt[(8 + e) * PT] = (bf16)(w1 & 0xffff); kt[(9 + e) * PT] = (bf16)(w1 >> 16); } }
        if (hw == 0) { const size_t row = (size_t)b * 4096 + c * 64 + lane; const float ig = GT[row * 8 + h] + gb[h]; float bc = logsigmoidf_(GT[row * 8 + 4 + h] + gb[4 + h]);
#pragma unroll
            for (int o = 1; o < 64; o <<= 1) { const float nb = __shfl_up(bc, o); if (lane >= o) bc += nb; }
            const float bl = __shfl(bc, 63), val = bl - bc + ig, a = wave_max(val); wt[lane] = __expf(val - a);
            if (lane == 0) { AB[2 * u] = a; AB[2 * u + 1] = bl; } }
        __syncthreads();
        { const float w = wt[s]; LAS bf16* vt = (LAS bf16*)hb + d16 * PT + s;
          const unsigned xs[8] = {x0.x, x0.y, x0.z, x0.w, x1.x, x1.y, x1.z, x1.w};
#pragma unroll
          for (int e = 0; e < 8; ++e) { const unsigned p = pkbf(bflo(xs[e]) * w, bfhi(xs[e]) * w); vt[(2 * e) * PT] = (bf16)(p & 0xffff); vt[(2 * e + 1) * PT] = (bf16)(p >> 16); } }
        __syncthreads();
        {
            bf16x8 af[2];
#pragma unroll
            for (int ks = 0; ks < 2; ++ks) af[ks] = *(const LAS bf16x8*)(hb + ((hw * 16 + qi) * PT + ks * 32 + g * 8) * 2);
            float* cp = Cb + (size_t)u * 4096 + (hw * 16 + 4 * g) * 64 + qi;
#pragma unroll
            for (int kb = 0; kb < 4; ++kb) { f32x4 acc = (f32x4){0.f, 0.f, 0.f, 0.f};
#pragma unroll
                for (int ks = 0; ks < 2; ++ks) { const bf16x8 bfr = *(const LAS bf16x8*)(hb + 9216 + ((kb * 16 + qi) * PT + ks * 32 + g * 8) * 2); acc = __builtin_amdgcn_mfma_f32_16x16x32_bf16(af[ks], bfr, acc, 0, 0, 0); }
                cp[0 * 64 + kb * 16] = acc[0]; cp[1 * 64 + kb * 16] = acc[1]; cp[2 * 64 + kb * 16] = acc[2]; cp[3 * 64 + kb * 16] = acc[3]; }
            if (ht < 64) { float n = 0.f; const LAS bf16* kr = (const LAS bf16*)(hb + 9216) + ht * PT;
#pragma unroll 8
                for (int ss = 0; ss < 64; ++ss) n += wt[ss] * bf2f(kr[ss]);
                Nb[(size_t)u * 64 + ht] = n; }
        }
        __syncthreads();
    }
}
__device__ __forceinline__ void mlstm_scan(CArgs& A) {
    const int gt = bidx() * 512 + tidx(), NGT = gdim() * 512;
    float* Cb = (float*)((unsigned char*)A.out + OUT_C); float* Nb = (float*)(A.ws + WS_NST); const float* AB = (const float*)(A.ws + WS_AB); float* MS = (float*)(A.ws + WS_MS);
    for (int idx = gt; idx < 64 * 4160; idx += NGT) { const int bh = idx / 4160, e = idx % 4160; float st = 0.f, m = 0.f;
        float* base = e < 4096 ? Cb + (size_t)bh * 64 * 4096 + e : Nb + (size_t)bh * 64 * 64 + (e - 4096); const size_t stride = e < 4096 ? 4096 : 64;
        for (int c0 = 0; c0 < 64; c0 += 8) { float d[8], a[8], bl[8];
#pragma unroll
            for (int j = 0; j < 8; ++j) { d[j] = base[(size_t)(c0 + j) * stride]; a[j] = AB[2 * (bh * 64 + c0 + j)]; bl[j] = AB[2 * (bh * 64 + c0 + j) + 1]; }
#pragma unroll
            for (int j = 0; j < 8; ++j) { base[(size_t)(c0 + j) * stride] = st; if (e == 0) MS[bh * 64 + c0 + j] = m;
                const float mn = fmaxf(bl[j] + m, a[j]); st = __expf(bl[j] + m - mn) * st + __expf(a[j] - mn) * d[j]; m = mn; } } }
}
__device__ __forceinline__ void mlstm_out(CArgs& A, LAS unsigned char* lds, int l) {
    l = lnd(l);
    const int tid = tidx(), lane = tid & 63, wave = tid >> 6, half = wave >> 2, hw = wave & 3, ht = tid & 255, qi = lane & 15, g = lane >> 4;
    constexpr int PT = 72, HB = 40960;
    LAS unsigned char* hb = lds + half * HB; LAS float* tb = (LAS float*)(hb + 27648);
    const bf16* P = (const bf16*)(A.ws + WS_HP); const float* GT = (const float*)(A.ws + WS_GATES); const float* gb = A.in[10] + l * 8;
    const float* Cb = (const float*)((unsigned char*)A.out + OUT_C); const float* Nb = (const float*)(A.ws + WS_NST); const float* MS = (const float*)(A.ws + WS_MS); bf16* CAT = (bf16*)(A.ws + WS_CAT);
    const float* ng = A.in[11] + l * 256;
    for (int u0 = bidx() * 2; u0 < 4096; u0 += gdim() * 2) {
        const int u = u0 + half, bh = u >> 6, c = u & 63, b = bh >> 2, h = bh & 3;
        { const int s = ht >> 2, d16 = (ht & 3) * 16, pos = c * 64 + s; const size_t prow = ((size_t)b * 4096 + pos) * NPJ;
          float k0[8], k1[8]; conv8(A, l, P, b, pos, 1792 + h * 64 + d16, 256 + h * 64 + d16, k0); conv8(A, l, P, b, pos, 1792 + h * 64 + d16 + 8, 256 + h * 64 + d16 + 8, k1);
          v4u w; w.x = pkbf(k0[0] * 0.125f, k0[1] * 0.125f); w.y = pkbf(k0[2] * 0.125f, k0[3] * 0.125f); w.z = pkbf(k0[4] * 0.125f, k0[5] * 0.125f); w.w = pkbf(k0[6] * 0.125f, k0[7] * 0.125f);
          *(LAS v4u*)(hb + (s * PT + d16) * 2) = w;
          w.x = pkbf(k1[0] * 0.125f, k1[1] * 0.125f); w.y = pkbf(k1[2] * 0.125f, k1[3] * 0.125f); w.z = pkbf(k1[4] * 0.125f, k1[5] * 0.125f); w.w = pkbf(k1[6] * 0.125f, k1[7] * 0.125f);
          *(LAS v4u*)(hb + (s * PT + d16 + 8) * 2) = w;
          const v4u x0 = *(const v4u*)(P + prow + 2048 + h * 64 + d16), x1 = *(const v4u*)(P + prow + 2048 + h * 64 + d16 + 8);
          LAS bf16* vt = (LAS bf16*)(hb + 9216) + d16 * PT + s;
          vt[0 * PT] = (bf16)(x0.x & 0xffff); vt[1 * PT] = (bf16)(x0.x >> 16); vt[2 * PT] = (bf16)(x0.y & 0xffff); vt[3 * PT] = (bf16)(x0.y >> 16);
          vt[4 * PT] = (bf16)(x0.z & 0xffff); vt[5 * PT] = (bf16)(x0.z >> 16); vt[6 * PT] = (bf16)(x0.w & 0xffff); vt[7 * PT] = (bf16)(x0.w >> 16);
          vt[8 * PT] = (bf16)(x1.x & 0xffff); vt[9 * PT] = (bf16)(x1.x >> 16); vt[10 * PT] = (bf16)(x1.y & 0xffff); vt[11 * PT] = (bf16)(x1.y >> 16);
          vt[12 * PT] = (bf16)(x1.z & 0xffff); vt[13 * PT] = (bf16)(x1.z >> 16); vt[14 * PT] = (bf16)(x1.w & 0xffff); vt[15 * PT] = (bf16)(x1.w >> 16);
          const float* cp = Cb + (size_t)u * 4096 + s * 64 + d16;
          const f32x4 c0 = *(const f32x4*)cp, c1 = *(const f32x4*)(cp + 4), c2 = *(const f32x4*)(cp + 8), c3 = *(const f32x4*)(cp + 12);
          w.x = pkbf(c0[0], c0[1]); w.y = pkbf(c0[2], c0[3]); w.z = pkbf(c1[0], c1[1]); w.w = pkbf(c1[2], c1[3]); *(LAS v4u*)(hb + 18432 + (s * PT + d16) * 2) = w;
          w.x = pkbf(c2[0], c2[1]); w.y = pkbf(c2[2], c2[3]); w.z = pkbf(c3[0], c3[1]); w.w = pkbf(c3[2], c3[3]); *(LAS v4u*)(hb + 18432 + (s * PT + d16 + 8) * 2) = w;
          if (ht < 64) tb[256 + ht] = Nb[(size_t)u * 64 + ht]; }
        if (hw == 0) { const size_t row = (size_t)b * 4096 + c * 64 + lane; const float ig = GT[row * 8 + h] + gb[h]; float bc = logsigmoidf_(GT[row * 8 + 4 + h] + gb[4 + h]);
#pragma unroll
            for (int o = 1; o < 64; o <<= 1) { const float nb = __shfl_up(bc, o); if (lane >= o) bc += nb; }
            const float gs = ig - bc; float pm = gs;
#pragma unroll
            for (int o = 1; o < 64; o <<= 1) { const float nb = __shfl_up(pm, o); if (lane >= o) pm = fmaxf(pm, nb); }
            const float mc = MS[u], Mt = fmaxf(mc, pm);
            tb[lane] = gs; tb[64 + lane] = Mt; tb[128 + lane] = __expf(mc - Mt); tb[192 + lane] = __expf(-(bc + Mt)); }
        const int tl = hw * 16 + qi; bf16x8 qf[2]; float nq = 0.f;
        float qv[2][8];
#pragma unroll
        for (int ks = 0; ks < 2; ++ks) { conv8(A, l, P, b, c * 64 + tl, 1536 + h * 64 + ks * 32 + g * 8, h * 64 + ks * 32 + g * 8, qv[ks]);
            v4u w; w.x = pkbf(qv[ks][0], qv[ks][1]); w.y = pkbf(qv[ks][2], qv[ks][3]); w.z = pkbf(qv[ks][4], qv[ks][5]); w.w = pkbf(qv[ks][6], qv[ks][7]); qf[ks] = __builtin_bit_cast(bf16x8, w); }
        __syncthreads();
#pragma unroll
        for (int ks = 0; ks < 2; ++ks) { const f32x4 n0 = *(const LAS f32x4*)(tb + 256 + ks * 32 + g * 8), n1 = *(const LAS f32x4*)(tb + 256 + ks * 32 + g * 8 + 4);
            nq += (qv[ks][0] * n0[0] + qv[ks][1] * n0[1]) + (qv[ks][2] * n0[2] + qv[ks][3] * n0[3]) + (qv[ks][4] * n1[0] + qv[ks][5] * n1[1]) + (qv[ks][6] * n1[2] + qv[ks][7] * n1[3]); }
        nq += __shfl_xor(nq, 16); nq += __shfl_xor(nq, 32);
        const float Mt = tb[64 + tl], inter = tb[128 + tl], emt = tb[192 + tl];
        bf16x8 pf[2]; float dsum = 0.f;
#pragma unroll
        for (int tg = 0; tg < 2; ++tg) { f32x4 sv[2];
#pragma unroll
            for (int j = 0; j < 2; ++j) { sv[j] = (f32x4){0.f, 0.f, 0.f, 0.f}; const int rowp = 32 * tg + 8 * (qi >> 2) + 4 * j + (qi & 3);
#pragma unroll
                for (int ks = 0; ks < 2; ++ks) { const bf16x8 a = *(const LAS bf16x8*)(hb + (rowp * PT + ks * 32 + g * 8) * 2); sv[j] = __builtin_amdgcn_mfma_f32_16x16x32_bf16(a, qf[ks], sv[j], 0, 0, 0); }
                const int s0 = 32 * tg + 8 * g + 4 * j; const f32x4 gsv = *(const LAS f32x4*)(tb + s0);
#pragma unroll
                for (int r = 0; r < 4; ++r) { const float pv = (s0 + r <= tl) ? sv[j][r] * __expf(gsv[r] - Mt) : 0.f; sv[j][r] = pv; dsum += pv; } }
            v4u pw; pw.x = pkbf(sv[0][0], sv[0][1]); pw.y = pkbf(sv[0][2], sv[0][3]); pw.z = pkbf(sv[1][0], sv[1][1]); pw.w = pkbf(sv[1][2], sv[1][3]); pf[tg] = __builtin_bit_cast(bf16x8, pw); }
        dsum += __shfl_xor(dsum, 16); dsum += __shfl_xor(dsum, 32);
        const float den = fmaxf(fabsf(dsum + inter * nq), emt), iden = 1.f / den;
        f32x4 o1[4], o2[4]; float ssq = 0.f;
#pragma unroll
        for (int db = 0; db < 4; ++db) { o1[db] = (f32x4){0.f, 0.f, 0.f, 0.f}; o2[db] = (f32x4){0.f, 0.f, 0.f, 0.f};
#pragma unroll
            for (int tg = 0; tg < 2; ++tg) { const bf16x8 a = *(const LAS bf16x8*)(hb + 9216 + ((db * 16 + qi) * PT + tg * 32 + g * 8) * 2); o1[db] = __builtin_amdgcn_mfma_f32_16x16x32_bf16(a, pf[tg], o1[db], 0, 0, 0); }
#pragma unroll
            for (int ks = 0; ks < 2; ++ks) { const bf16x8 a = *(const LAS bf16x8*)(hb + 18432 + ((db * 16 + qi) * PT + ks * 32 + g * 8) * 2); o2[db] = __builtin_amdgcn_mfma_f32_16x16x32_bf16(a, qf[ks], o2[db], 0, 0, 0); }
            o1[db] = (o1[db] + o2[db] * inter) * iden; ssq += (o1[db][0] * o1[db][0] + o1[db][1] * o1[db][1]) + (o1[db][2] * o1[db][2] + o1[db][3] * o1[db][3]); }
        ssq += __shfl_xor(ssq, 16); ssq += __shfl_xor(ssq, 32);
        const float rs = 1.f / sqrtf(ssq * (1.f / 64.f) + EPS); const size_t row = (size_t)b * 4096 + c * 64 + tl;
#pragma unroll
        for (int db = 0; db < 4; ++db) { const int vcol = h * 64 + db * 16 + 4 * g; const v2u mo = *(const v2u*)(P + row * NPJ + 2304 + vcol); const f32x4 gv = *(const f32x4*)(ng + vcol);
            v2u w; w.x = pkbf(o1[db][0] * rs * gv[0] * sigmoidf_(bflo(mo.x)), o1[db][1] * rs * gv[1] * sigmoidf_(bfhi(mo.x))); w.y = pkbf(o1[db][2] * rs * gv[2] * sigmoidf_(bflo(mo.y)), o1[db][3] * rs * gv[3] * sigmoidf_(bfhi(mo.y)));
            *(v2u*)(CAT + row * DM + 512 + vcol) = w; }
        __syncthreads();
    }
}
__device__ __forceinline__ void s5_scan(CArgs& A, int l) {
    l = lnd(l);
    const int gt = bidx() * 512 + tidx(), NGT = gdim() * 512;
    const float* E = (const float*)(A.ws + WS_EOUT); const float* LAML = (const float*)(A.ws + WS_LAML) + l * LAML_L; bf16* SUX = (bf16*)((unsigned char*)A.out + OUT_SUX);
    for (int idx = gt; idx < 16384; idx += NGT) { const int b = idx >> 10, g = (idx >> 6) & 15, p = idx & 63; const float lr = LAML[2 * (g * 64 + p)], li = LAML[2 * (g * 64 + p) + 1]; float xr = 0.f, xi = 0.f;
        for (int c0 = 0; c0 < 64; c0 += 8) { f32x2 e[8];
#pragma unroll
            for (int j = 0; j < 8; ++j) e[j] = *(const f32x2*)(E + ((size_t)g * 1024 + b * 64 + c0 + j) * 128 + 2 * p);
#pragma unroll
            for (int j = 0; j < 8; ++j) { *(unsigned*)(SUX + ((size_t)g * 1024 + b * 64 + c0 + j) * 1152 + 1024 + 2 * p) = pkbf(xr, xi);
                const float nr = lr * xr - li * xi + e[j].x, ni = lr * xi + li * xr + e[j].y; xr = nr; xi = ni; } } }
}

#define XB_TMO      128
#define XB_XCNT(j)  (256  + 64 * (j))
#define XB_XSUB(j)  (1280 + 64 * (j))
#define XB_XGEN(j)  (2304 + 64 * (j))
#define XB_TOP      3328
#define XB_TOPGEN   3392
#define XCD_BAR_WORDS 3456
#define XB_SPIN_CAP (1u << 18)

__device__ __forceinline__ unsigned xb_ld(unsigned* p)              { return __hip_atomic_load(p, __ATOMIC_RELAXED, __HIP_MEMORY_SCOPE_AGENT); }
__device__ __forceinline__ unsigned xb_add(unsigned* p, unsigned v) { return __hip_atomic_fetch_add(p, v, __ATOMIC_RELAXED, __HIP_MEMORY_SCOPE_AGENT); }
__device__ __forceinline__ unsigned xb_xcc_id() { return (unsigned)__builtin_amdgcn_s_getreg((3 << 11) | 20) & 0xFu; }
#define XB_SPIN(cond, bar) do { unsigned _sp = 0; while (cond) { __builtin_amdgcn_s_sleep(1); \
    if ((++_sp & 255u) == 0u) { if (xb_ld(&(bar)[XB_TMO])) break; if (_sp > XB_SPIN_CAP) { atomicAdd(&(bar)[XB_TMO], 1u); break; } } } } while (0)

struct XcdBarrier {
    unsigned* bar; unsigned x;
    volatile LAS unsigned* st;
};

__device__ __forceinline__ XcdBarrier xcd_barrier_post(unsigned* bar, volatile LAS unsigned* st) {
    XcdBarrier b; b.bar = bar; b.x = xb_xcc_id(); b.st = st;
    if (threadIdx.x == 0) (void)xb_add(&bar[XB_XCNT(b.x)], 1u);
    return b;
}
__device__ __forceinline__ void xcd_barrier_complete(unsigned* bar, unsigned x, unsigned& nloc, unsigned& nx) {
    const unsigned G = gridDim.x * gridDim.y * gridDim.z;
    unsigned sum, cnt, mine, sp = 0u;
    for (;;) {
        sum = 0u; cnt = 0u; mine = 0u;
#pragma unroll
        for (unsigned j = 0; j < 16; ++j) { const unsigned c = xb_ld(&bar[XB_XCNT(j)]); sum += c; cnt += (c > 0u) ? 1u : 0u; mine = (j == x) ? c : mine; }
        if (sum == G) break;
        __builtin_amdgcn_s_sleep(1);
        if ((++sp & 255u) == 0u) { if (xb_ld(&bar[XB_TMO])) break; if (sp > XB_SPIN_CAP) { atomicAdd(&bar[XB_TMO], 1u); break; } }
    }
    nloc = mine > 0u ? mine : 1u; nx = cnt > 0u ? cnt : 1u;
}

__device__ __forceinline__ void xcd_barrier(const XcdBarrier& b) {
    asm volatile("s_waitcnt vmcnt(0)" ::: "memory");
    __syncthreads();
    if (threadIdx.x == 0) {
        unsigned* bar = b.bar;
        __builtin_amdgcn_s_waitcnt(0);
        unsigned nloc = b.st[0], nx = b.st[1];
        if (nloc == 0u) { xcd_barrier_complete(bar, b.x, nloc, nx); b.st[0] = nloc; b.st[1] = nx; }
        const unsigned old = xb_add(&bar[XB_XSUB(b.x)], 1u);
        const unsigned gen = old / nloc;
        if (old + 1u == (gen + 1u) * nloc) {
            __builtin_amdgcn_fence(__ATOMIC_RELEASE, "agent");
            asm volatile("s_waitcnt vmcnt(0)" ::: "memory");
            const unsigned og = xb_add(&bar[XB_TOP], 1u);
            const unsigned tg = og / nx;
            if (og + 1u == (tg + 1u) * nx) xb_add(&bar[XB_TOPGEN], 1u);
            else XB_SPIN(xb_ld(&bar[XB_TOPGEN]) == tg, bar);
            __builtin_amdgcn_fence(__ATOMIC_ACQUIRE, "agent");
            xb_add(&bar[XB_XGEN(b.x)], 1u);
            asm volatile("s_waitcnt vmcnt(0)" ::: "memory");
        } else {
            XB_SPIN(xb_ld(&bar[XB_XGEN(b.x)]) == gen, bar);
            __builtin_amdgcn_fence(__ATOMIC_ACQUIRE, "agent");
            asm volatile("s_waitcnt vmcnt(0)" ::: "memory");
        }
    }
    __syncthreads();
}

#ifndef PHMASK
#define PHMASK 0xFFFFFFFFu
#endif
#ifndef REPMASK
#define REPMASK 0u
#endif
#define REP(k) for (int rep_ = 0; rep_ < 1 + (int)((REPMASK >> (k)) & 1u); ++rep_)
#define A (*kargs())
#define ws (kargs()->ws)
#define Wb ((const bf16*)(ws + WS_W))
#define XB ((bf16*)(ws + WS_XB))
#define CAT ((bf16*)(ws + WS_CAT))
#define HP ((bf16*)(ws + WS_HP))
#define Y ((bf16*)(ws + WS_Y))
#define X (kargs()->out)
#define lng (kargs()->in[5] + lnd(l) * 4096)
#define lnb (kargs()->in[6] + lnd(l) * 4096)
__global__ void __launch_bounds__(512, 2) mega_fwd(Args unused_args) {
    extern __shared__ __attribute__((aligned(16))) unsigned char lds_raw[];
    LAS unsigned char* lds = (LAS unsigned char*)lds_raw;
    cg::grid_group grid = cg::this_grid();
    { volatile LAS unsigned* bst = (volatile LAS unsigned*)(lds + LDS_BYTES - 64); if (tidx() < 16) bst[tidx()] = 0u; __syncthreads();
      (void)xcd_barrier_post((unsigned*)(ws), bst); }
    grid.sync();
#define GSYNC() do { XcdBarrier b_; b_.bar = (unsigned*)(ws); b_.x = xb_xcc_id(); b_.st = (volatile LAS unsigned*)(lds + LDS_BYTES - 64); xcd_barrier(b_); } while (0)
    prep0(A);
    for (int l = 0; l < 2; ++l) {
#if (PHMASK >> 0) & 1
        REP(0)
        layer_prep1(A, lds, l);
#endif
        GSYNC();
#if (PHMASK >> 1) & 1
        REP(1)
        s5_ktab(A, l);
#endif
#if (PHMASK >> 2) & 1
        REP(2)
        { EpiKV E{(bf16*)(ws + WS_KX), (bf16*)(ws + WS_VTX)}; run_gemm(lds, (const bf16*)(ws + WS_MEMB), Wb + WO_KV, 4096, 2048, 1024, 1024, 1024, E); }
#endif
        GSYNC();
#if (PHMASK >> 3) & 1
        REP(3)
        s5_fill(A, l);
#endif
#if (PHMASK >> 4) & 1
        REP(4)
        { const float* rs1_ = (const float*)(ws + (lnd(l) == 0 ? WS_RSTID : WS_RSTAT)); EpiSwiGLU E{HP, LnFold{rs1_, ((const float*)(ws + WS_CC) + (size_t)lnd(l) * CC_L + CC_GU1), ((const float*)(ws + WS_CC) + (size_t)lnd(l) * CC_L + CC_N + CC_GU1)}}; run_gemm<EpiSwiGLU, true>(lds, (const bf16*)Y, Wb + WO_GU1, MT, 5632, 1024, 1024, 1024, E); }
#endif
        GSYNC();
#if (PHMASK >> 5) & 1
        REP(5)
        { const bool first = lnd(l) == 0; const bf16* xr_ = (const bf16*)Y;   const float* rs_ = (const float*)(ws + (first ? WS_RSTID : WS_RSTAT));
          const float* g_ = first ? (const float*)(ws + WS_ONES) : kargs()->in[5] + 3 * 1024; const float* b_ = first ? (const float*)(ws + WS_ZEROS) : kargs()->in[6] + 3 * 1024;
          EpiResid E{xr_, Y, 0.5f, rs_, g_, b_, (float*)(ws + WS_STATP)}; run_gemm(lds, HP, Wb + WO_D1, MT, 1024, 2816, 2816, 2816, E); }
#endif
        GSYNC();
#if (PHMASK >> 6) & 1
        REP(6)
        stat_finalize((float*)(ws + WS_STATP), (float*)(ws + WS_RSTAT));
#endif
        GSYNC();
#if (PHMASK >> 7) & 1
        REP(7)
        { EpiProj E{HP, (bf16*)((unsigned char*)(kargs()->out) + OUT_VT), (bf16*)((unsigned char*)(kargs()->out) + OUT_SUX), (const float*)(ws + WS_ROPE), (const float*)(ws + WS_ROPE) + 4096 * 32, LnFold{(const float*)(ws + WS_RSTAT), ((const float*)(ws + WS_CC) + (size_t)lnd(l) * CC_L + CC_IN), ((const float*)(ws + WS_CC) + (size_t)lnd(l) * CC_L + CC_N + CC_IN)}, (float*)(ws + WS_GATES)}; run_gemm<EpiProj, true>(lds, (const bf16*)Y, Wb + WO_IN, MT, 3072, 1024, 1024, 1024, E); }
#endif
        GSYNC();
#if (PHMASK >> 8) & 1
        REP(8)
        diffattn_phase(A, lds, l);
#endif
#if (PHMASK >> 9) & 1
        REP(9)
        mlstm_local(A, lds, l);
#endif
#if (PHMASK >> 10) & 1
        REP(10)
        { pg8::Gemm g{(const bf16*)((unsigned char*)(kargs()->out) + OUT_SUX), (const bf16*)(ws + WS_EM), 16384, 4096, 1024, 1152, 1024}; GroupOrder S; S.init(16, 4, 1, gdim(), bidx()); EpiS5E E{(float*)(ws + WS_EOUT)};
          pg8::gemm_phase<EpiS5E, GroupOrder, true, true>(lds, g, S, E); }
#endif
        GSYNC();
#if (PHMASK >> 22) & 1
        mlstm_scan(A); s5_scan(A, l);
#endif
        GSYNC();
#if (PHMASK >> 11) & 1
        REP(11)
        mlstm_out(A, lds, l);
#endif
#if (PHMASK >> 12) & 1
        REP(12)
        { pg8::Gemm g{(const bf16*)((unsigned char*)(kargs()->out) + OUT_SUX), (const bf16*)(ws + WS_TF), 16384, 16384, 1152, 1152, 1152}; GroupOrder S; S.init(16, 4, 4, gdim(), bidx()); EpiS5Y E{(bf16*)((unsigned char*)(kargs()->out) + OUT_YS5)};
          pg8::gemm_phase<EpiS5Y, GroupOrder, true, true>(lds, g, S, E); }
#endif
        GSYNC();
#if (PHMASK >> 23) & 1
        REP(23)
        { EpiGLU E{(const bf16*)((unsigned char*)(kargs()->out) + OUT_YS5), A.in[23] + lnd(l) * 256, CAT}; run_gemm(lds, (const bf16*)((unsigned char*)(kargs()->out) + OUT_YS5), Wb + WO_GLU, MT, 256, 256, 256, 256, E); }
#endif
        GSYNC();
#if (PHMASK >> 13) & 1
        REP(13)
        { EpiResid E{Y, Y, 1.0f, (const float*)(float*)(ws + WS_RSTAT), lng, lnb, (float*)(ws + WS_STATP)}; run_gemm(lds, CAT, Wb + WO_OUT, MT, 1024, 1024, 1024, 1024, E); }
#endif
        GSYNC();
#if (PHMASK >> 14) & 1
        REP(14)
        stat_finalize((float*)(ws + WS_STATP), (float*)(ws + WS_RSTAT));
#endif
        GSYNC();
#if (PHMASK >> 15) & 1
        REP(15)
        { EpiBf16 E{HP, LnFold{(const float*)(ws + WS_RSTAT), ((const float*)(ws + WS_CC) + (size_t)lnd(l) * CC_L + CC_Q), ((const float*)(ws + WS_CC) + (size_t)lnd(l) * CC_L + CC_N + CC_Q)}}; run_gemm<EpiBf16, true>(lds, (const bf16*)Y, Wb + WO_Q, MT, 1024, 1024, 1024, 1024, E); }
#endif
        GSYNC();
#if (PHMASK >> 16) & 1
        REP(16)
        xattn_phase(A, lds);
#endif
        GSYNC();
#if (PHMASK >> 17) & 1
        REP(17)
        { EpiResid E{Y, Y, 1.0f, (const float*)(float*)(ws + WS_RSTAT), lng + 1024, lnb + 1024, (float*)(ws + WS_STATP)}; run_gemm(lds, (const bf16*)(ws + WS_HP + 128 * MiB), Wb + WO_O, MT, 1024, 1024, 1024, 1024, E); }
#endif
        GSYNC();
#if (PHMASK >> 18) & 1
        REP(18)
        stat_finalize((float*)(ws + WS_STATP), (float*)(ws + WS_RSTAT));
#endif
        GSYNC();
#if (PHMASK >> 19) & 1
        REP(19)
        { EpiSwiGLU E{HP, LnFold{(const float*)(ws + WS_RSTAT), ((const float*)(ws + WS_CC) + (size_t)lnd(l) * CC_L + CC_GU2), ((const float*)(ws + WS_CC) + (size_t)lnd(l) * CC_L + CC_N + CC_GU2)}}; run_gemm<EpiSwiGLU, true>(lds, (const bf16*)Y, Wb + WO_GU2, MT, 5632, 1024, 1024, 1024, E); }
#endif
        GSYNC();
#if (PHMASK >> 20) & 1
        REP(20)
        { EpiResid E{Y, Y, 0.5f, (const float*)(float*)(ws + WS_RSTAT), lng + 2048, lnb + 2048, (float*)(ws + WS_STATP)}; run_gemm(lds, HP, Wb + WO_D2, MT, 1024, 2816, 2816, 2816, E); }
#endif
        GSYNC();
#if (PHMASK >> 21) & 1
        REP(21)
        if (lnd(l) == 1) ln_phase(Y, lng + 3072, lnb + 3072, X, nullptr, nullptr, nullptr, (float*)(ws + WS_RSTAT));
        else stat_finalize((float*)(ws + WS_STATP), (float*)(ws + WS_RSTAT));
#endif
        GSYNC();
    }
}

#undef ws
#undef Wb
#undef XB
#undef CAT
#undef HP
#undef Y
#undef X
#undef lng
#undef lnb
#undef A
extern "C" void kernel_launch(void* const* d_in, const int* in_sizes, int n_in, void* d_out, int out_size, void* d_ws, size_t ws_size, hipStream_t stream) {
    static int grid = 0;
    if (grid == 0) {
        if (n_in != 28 || out_size != MT * DM || ws_size < WS_END) { fprintf(stderr, "kernel_launch: unexpected problem (n_in %d out %d ws %zu)\n", n_in, out_size, ws_size); grid = -1; return; }
        int dev = 0, cus = 0, per_cu = 0;
        hipGetDevice(&dev); hipDeviceGetAttribute(&cus, hipDeviceAttributeMultiprocessorCount, dev);
        hipFuncSetAttribute((const void*)mega_fwd, hipFuncAttributeMaxDynamicSharedMemorySize, LDS_BYTES);
        hipOccupancyMaxActiveBlocksPerMultiprocessor(&per_cu, (const void*)mega_fwd, 512, LDS_BYTES);
        if (per_cu < 1) per_cu = 1;
        (void)hipGetLastError();
        grid = cus * per_cu;
    }
    if (grid < 0) return;
    if (hipMemsetAsync(d_ws, 0, 327680, stream) != hipSuccess) { fprintf(stderr, "memset failed\n"); return; }
    Args a{};
    for (int i = 0; i < 28; ++i) a.in[i] = (const float*)d_in[i];
    a.out = (float*)d_out; a.ws = (unsigned char*)d_ws;
    void* args[] = {&a};
    hipError_t e = hipLaunchCooperativeKernel((const void*)mega_fwd, dim3(grid), dim3(512), args, LDS_BYTES, stream);
    if (e != hipSuccess) fprintf(stderr, "cooperative launch failed: %s (grid %d)\n", hipGetErrorString(e), grid);
}
```

```cpp
#include <hip/hip_runtime.h>
#include <hip/hip_cooperative_groups.h>
#include <cstdio>
#include <cstdint>
namespace cg = cooperative_groups;
__device__ __forceinline__ int tidx() { int t = threadIdx.x; asm volatile("" : "+v"(t)); return t; }
__device__ __forceinline__ int bidx() { int t = blockIdx.x; asm volatile("" : "+s"(t)); return t; }
__device__ __forceinline__ int gdim() { int t = gridDim.x; asm volatile("" : "+s"(t)); return t; }
__device__ __forceinline__ int lnd(int v) { asm volatile("" : "+s"(v)); return v; }
namespace pg8 {
#define PG8_LAS __attribute__((address_space(3)))
typedef unsigned short bf16_t;
typedef short bf16x8 __attribute__((ext_vector_type(8)));
typedef float f32x4 __attribute__((ext_vector_type(4)));
typedef unsigned u32x4 __attribute__((ext_vector_type(4)));
constexpr int BM = 256, BK = 64, HALF = 128, HTB = HALF * BK * 2  , STAGE_BYTES = 8 * HTB, NXCD = 8, WGM = 8;

__host__ __device__ __forceinline__ int lds_byte(int r, int c) { const int st = (r >> 4) * 2 + (c >> 5), rr = r & 15, cc = c & 31, ob = rr * 64 + cc * 2; return st * 1024 + (ob ^ (((ob >> 9) & 1) << 5)); }
__host__ __device__ __forceinline__ void stage_rc(int b, int& R, int& C) { const int st = b / 1024, sb = b % 1024, swz = sb ^ (((sb >> 9) & 1) << 5); R = (st >> 1) * 16 + swz / 64; C = (st & 1) * 32 + (swz % 64) / 2; }
__host__ __device__ __forceinline__ int perm32(int rho) { const int n = rho >> 4, i = rho & 15; return 8 * (i >> 2) + 4 * n + (i & 3); }

struct Unit { int pm, pn; };
struct Gemm { const bf16_t* A; const bf16_t* Bt; int M, N, K, lda, ldb; };

struct StaticOrder {
    int nM, nN, nwg, G, c;
    __host__ __device__ void init(int M, int N, int G_, int c_) { nM = M / BM; nN = N / BM; nwg = nM * nN; G = G_; c = c_; }
    __host__ __device__ bool next(int i, Unit& u) const {
        const long L = (long)i * G + c; if (L >= nwg) return false;
        int wgid = (int)L; { const int q = nwg / NXCD, r = nwg % NXCD, xcd = wgid % NXCD, off = wgid / NXCD; wgid = (xcd < r ? xcd * (q + 1) : r * (q + 1) + (xcd - r) * q) + off; }
        const int nig = WGM * nN, gid = wgid / nig, fm = gid * WGM, gsz = (nM - fm) < WGM ? (nM - fm) : WGM;
        u.pm = fm + ((wgid % nig) % gsz); u.pn = (wgid % nig) / gsz; return true;
    }
    __device__ __forceinline__ void a_ready(const Unit&) const {}
    __device__ __forceinline__ void done(const Unit&) const {}
};

__device__ __forceinline__ unsigned cvt_pk_bf16(float lo, float hi) { unsigned r; asm volatile("v_cvt_pk_bf16_f32 %0, %1, %2" : "=v"(r) : "v"(lo), "v"(hi)); return r; }
typedef float f32x2 __attribute__((ext_vector_type(2)));
typedef _Float16 f16x8_t __attribute__((ext_vector_type(8)));
template <bool F16> __device__ __forceinline__ f32x4 mma16(bf16x8 a, bf16x8 b, f32x4 c) {
    if constexpr (F16) return __builtin_amdgcn_mfma_f32_16x16x32_f16(__builtin_bit_cast(f16x8_t, a), __builtin_bit_cast(f16x8_t, b), c, 0, 0, 0);
    else return __builtin_amdgcn_mfma_f32_16x16x32_bf16(a, b, c, 0, 0, 0);
}
template <class Epi, class Sched, bool ALIGN_EPI = false, bool SP2 = false, bool F16 = false>
__device__ __forceinline__ void gemm_phase(PG8_LAS unsigned char* lds, const Gemm g, const Sched& S, const Epi& E) {
    const int tid = tidx(), wid = __builtin_amdgcn_readfirstlane(tid >> 6), lane = tid & 63, wr = wid >> 2, wc = wid & 3, fr = lane & 15, fq = lane >> 4;
    const int K = g.K, nt = K / BK, lda = g.lda, ldb = g.ldb;
    unsigned voffA[2], voffB[2];
#pragma unroll
    for (int i = 0; i < 2; ++i) { int R, C; stage_rc(tid * 16 + i * 8192, R, C); const int Rb = Epi::PERM ? ((R & ~31) + perm32(R & 31)) : R;
        voffA[i] = (unsigned)(R * lda + C) * 2u; voffB[i] = (unsigned)(Rb * ldb + C) * 2u; }
    const size_t kstep = (size_t)(BK * 2);
    const size_t hstepA = (size_t)HALF * lda * 2, hstepB = (size_t)HALF * ldb * 2;
    const size_t tstepA = 2 * hstepA, tstepB = 2 * hstepB;
    const unsigned ldsw = (unsigned)wid * 1024u;
    const int aoff = lds_byte(wr * 64 + fr, fq * 8), boff = lds_byte(wc * 32 + fr, fq * 8);
#define PG8_SA(b, h) (((b) * 2 + (h)) * HTB)
#define PG8_SB(b, h) ((4 + (b) * 2 + (h)) * HTB)
#define PG8_STAGE(bufoff, gbase, voff) do { _Pragma("unroll") for (int _i = 0; _i < 2; ++_i) \
        __builtin_amdgcn_global_load_lds((const unsigned*)((const char*)(gbase) + (voff)[_i]), (PG8_LAS unsigned*)(lds + (bufoff) + ldsw + _i * 8192), 16, 0, 0); } while (0)
#define PG8_LDA(dst, b, h) do { _Pragma("unroll") for (int m = 0; m < 4; ++m) _Pragma("unroll") for (int k = 0; k < 2; ++k) dst[m][k] = *(const PG8_LAS bf16x8*)(lds + PG8_SA(b, h) + aoff + m * 2048 + k * 1024); } while (0)
#define PG8_LDB(dst, b, h) do { _Pragma("unroll") for (int n = 0; n < 2; ++n) _Pragma("unroll") for (int k = 0; k < 2; ++k) dst[n][k] = *(const PG8_LAS bf16x8*)(lds + PG8_SB(b, h) + boff + n * 2048 + k * 1024); } while (0)
#define PG8_MMA(ai, bj, At, Bt) do { __builtin_amdgcn_s_setprio(1); _Pragma("unroll") for (int m = 0; m < 4; ++m) _Pragma("unroll") for (int n = 0; n < 2; ++n) _Pragma("unroll") for (int k = 0; k < 2; ++k) \
        acc[ai][bj][m][n] = mma16<F16>(Bt[n][k], At[m][k], acc[ai][bj][m][n]); __builtin_amdgcn_s_setprio(0); } while (0)
#define PG8_WAIT_V(n) asm volatile("s_waitcnt vmcnt(" #n ")" ::: "memory")
#define PG8_WAIT_L(n) asm volatile("s_waitcnt lgkmcnt(" #n ")" ::: "memory")
#define PG8_BAR __builtin_amdgcn_s_barrier()
#define PG8_SCHED __builtin_amdgcn_sched_barrier(0)
    Unit cur, nxt; int ui = 0;
    if (!S.next(0, cur)) return;
    f32x4 acc[2][2][4][2];
#pragma unroll
    for (int a = 0; a < 2; ++a)
#pragma unroll
        for (int b = 0; b < 2; ++b)
#pragma unroll
            for (int m = 0; m < 4; ++m)
#pragma unroll
                for (int n = 0; n < 2; ++n) acc[a][b][m][n] = (f32x4){0.f, 0.f, 0.f, 0.f};
    bf16x8 At[4][2], B0[2][2], B1[2][2];
    const char* cA = (const char*)g.A + (size_t)cur.pm * tstepA; const char* cB = (const char*)g.Bt + (size_t)cur.pn * tstepB;
    S.a_ready(cur);
    if constexpr (SP2) {
        PG8_STAGE(PG8_SB(0, 0), cB, voffB); PG8_STAGE(PG8_SB(0, 1), cB + hstepB, voffB); PG8_STAGE(PG8_SA(0, 0), cA, voffA); PG8_STAGE(PG8_SA(0, 1), cA + hstepA, voffA);
        if (wr == 1) PG8_BAR;
        PG8_WAIT_V(2); PG8_BAR;
        PG8_STAGE(PG8_SB(1, 0), cB + kstep, voffB); PG8_STAGE(PG8_SA(1, 0), cA + kstep, voffA); PG8_STAGE(PG8_SB(1, 1), cB + hstepB + kstep, voffB);
        PG8_WAIT_V(6); PG8_BAR;
    } else {
        PG8_STAGE(PG8_SB(0, 0), cB, voffB); PG8_STAGE(PG8_SA(0, 0), cA, voffA); PG8_STAGE(PG8_SB(0, 1), cB + hstepB, voffB); PG8_STAGE(PG8_SA(0, 1), cA + hstepA, voffA);
        if (wr == 1) PG8_BAR;
        PG8_WAIT_V(4); PG8_BAR;
        PG8_STAGE(PG8_SB(1, 0), cB + kstep, voffB); PG8_STAGE(PG8_SA(1, 0), cA + kstep, voffA); PG8_STAGE(PG8_SB(1, 1), cB + hstepB + kstep, voffB);
        PG8_WAIT_V(6); PG8_BAR;
    }
    for (;;) {
        const bool has_next = S.next(ui + 1, nxt);
        const char* nA = has_next ? (const char*)g.A + (size_t)nxt.pm * tstepA : cA; const char* nB = has_next ? (const char*)g.Bt + (size_t)nxt.pn * tstepB : cB;
        for (int t = 0; t < nt; t += 2) {
            const bool last = (t == nt - 2);
            const char* a1 = cA + (size_t)(t + 1) * kstep;
            const char* a2 = last ? nA : cA + (size_t)(t + 2) * kstep; const char* b2 = last ? nB : cB + (size_t)(t + 2) * kstep;
            const char* a3 = a2 + kstep; const char* b3 = b2 + kstep;
            if (last && has_next) S.a_ready(nxt);
            if constexpr (SP2) {
            PG8_LDB(B0, 0, 0); PG8_LDB(B1, 0, 1); PG8_SCHED; PG8_LDA(At, 0, 0); PG8_STAGE(PG8_SA(1, 1), a1 + hstepA, voffA);
            PG8_WAIT_V(8); PG8_WAIT_L(0); PG8_BAR; PG8_MMA(0, 0, At, B0); PG8_MMA(0, 1, At, B1); PG8_BAR; PG8_SCHED;
            PG8_LDA(At, 0, 1); PG8_STAGE(PG8_SB(0, 0), b2, voffB); PG8_STAGE(PG8_SB(0, 1), b2 + hstepB, voffB); PG8_STAGE(PG8_SA(0, 0), a2, voffA);
            PG8_WAIT_V(8); PG8_WAIT_L(0); PG8_BAR; PG8_MMA(1, 0, At, B0); PG8_MMA(1, 1, At, B1); PG8_BAR; PG8_SCHED;
            PG8_LDB(B0, 1, 0); PG8_LDB(B1, 1, 1); PG8_SCHED; PG8_LDA(At, 1, 0); PG8_STAGE(PG8_SA(0, 1), a2 + hstepA, voffA);
            PG8_WAIT_V(8); PG8_WAIT_L(0); PG8_BAR; PG8_MMA(0, 0, At, B0); PG8_MMA(0, 1, At, B1); PG8_BAR; PG8_SCHED;
            PG8_LDA(At, 1, 1); PG8_STAGE(PG8_SB(1, 0), b3, voffB); PG8_STAGE(PG8_SB(1, 1), b3 + hstepB, voffB); PG8_STAGE(PG8_SA(1, 0), a3, voffA);
            PG8_WAIT_V(8); PG8_WAIT_L(0); PG8_BAR; PG8_MMA(1, 0, At, B0); PG8_MMA(1, 1, At, B1); PG8_BAR; PG8_SCHED;
            } else {
            PG8_LDB(B0, 0, 0); PG8_SCHED; PG8_LDA(At, 0, 0); PG8_STAGE(PG8_SA(1, 1), a1 + hstepA, voffA);
            PG8_WAIT_L(8); PG8_BAR; PG8_WAIT_L(0); PG8_MMA(0, 0, At, B0); PG8_BAR; PG8_SCHED;
            PG8_LDB(B1, 0, 1); PG8_STAGE(PG8_SB(0, 0), b2, voffB);
            PG8_BAR; PG8_WAIT_L(0); PG8_MMA(0, 1, At, B1); PG8_BAR;
            PG8_LDA(At, 0, 1); PG8_STAGE(PG8_SA(0, 0), a2, voffA);
            PG8_BAR; PG8_WAIT_L(0); PG8_MMA(1, 0, At, B0); PG8_BAR; PG8_SCHED;
            PG8_STAGE(PG8_SB(0, 1), b2 + hstepB, voffB);
            PG8_WAIT_V(6); PG8_BAR; PG8_MMA(1, 1, At, B1); PG8_BAR;
            PG8_LDB(B0, 1, 0); PG8_SCHED; PG8_LDA(At, 1, 0); PG8_STAGE(PG8_SA(0, 1), a2 + hstepA, voffA);
            PG8_WAIT_L(8); PG8_BAR; PG8_WAIT_L(0); PG8_MMA(0, 0, At, B0); PG8_BAR; PG8_SCHED;
            PG8_LDB(B1, 1, 1); PG8_STAGE(PG8_SB(1, 0), b3, voffB);
            PG8_BAR; PG8_WAIT_L(0); PG8_MMA(0, 1, At, B1); PG8_BAR;
            PG8_LDA(At, 1, 1); PG8_STAGE(PG8_SA(1, 0), a3, voffA);
            PG8_BAR; PG8_WAIT_L(0); PG8_MMA(1, 0, At, B0); PG8_BAR; PG8_SCHED;
            PG8_STAGE(PG8_SB(1, 1), b3 + hstepB, voffB);
            PG8_WAIT_V(6); PG8_BAR; PG8_MMA(1, 1, At, B1); PG8_BAR;
            }
        }
        if constexpr (ALIGN_EPI) { if (wr == 0) PG8_BAR; }
        if constexpr (!Epi::AFTER_DRAIN) { E(acc, cur, wr, wc, fr, fq); S.done(cur); }
        if (!has_next) break;
#pragma unroll
        for (int a = 0; a < 2; ++a)
#pragma unroll
            for (int b = 0; b < 2; ++b)
#pragma unroll
                for (int m = 0; m < 4; ++m)
#pragma unroll
                    for (int n = 0; n < 2; ++n) acc[a][b][m][n] = (f32x4){0.f, 0.f, 0.f, 0.f};
        cur = nxt; cA = nA; cB = nB; ++ui;
        if constexpr (ALIGN_EPI) { if (wr == 1) PG8_BAR; }
    }
    PG8_WAIT_V(0);
    if constexpr (!ALIGN_EPI) { if (wr == 0) PG8_BAR; }
    PG8_BAR;
    if constexpr (Epi::AFTER_DRAIN) { E.fused(acc, cur, wr, wc, fr, fq, lds, wid, lane); S.done(cur); }
#undef PG8_SA
#undef PG8_SB
#undef PG8_STAGE
#undef PG8_LDA
#undef PG8_LDB
#undef PG8_MMA
#undef PG8_WAIT_V
#undef PG8_WAIT_L
#undef PG8_BAR
#undef PG8_SCHED
}
}

#define LAS __attribute__((address_space(3)))
typedef unsigned short bf16;
typedef unsigned v4u __attribute__((ext_vector_type(4)));
typedef unsigned v2u __attribute__((ext_vector_type(2)));
typedef float f32x4 __attribute__((ext_vector_type(4)));
typedef float f32x2 __attribute__((ext_vector_type(2)));
typedef short bf16x8 __attribute__((ext_vector_type(8)));
using pg8::Unit;

constexpr int SEQ = 4096, NB = 16, DM = 1024, MT = NB * SEQ, DFF = 2816, DINW = 2824, NPJ = 2816;
constexpr float ALPHA = 1.41421356237309515f, EPS = 1e-5f, LOG2E = 1.4426950408889634f;
constexpr size_t MiB = 1u << 20;
constexpr size_t WS_ROPE = 1 * MiB, WS_GATES = 2 * MiB, WS_WG = 4 * MiB, WS_MEMB = 5 * MiB, WS_W = 16 * MiB, WS_TF = 68 * MiB, WS_EM = 104 * MiB,
    WS_KX = 112 * MiB, WS_VTX = 120 * MiB, WS_XB = 128 * MiB, WS_CAT = 256 * MiB, WS_HP = 384 * MiB, WS_Y = 736 * MiB,
    WS_NST = 992 * MiB, WS_AB = 993 * MiB, WS_MS = 993 * MiB + 512 * 1024, WS_EOUT = 994 * MiB, WS_POW = 1002 * MiB, WS_BBAR = 1004 * MiB,
    WS_KTAB = 1005 * MiB, WS_LAML = 1006 * MiB, WS_END = 1009 * MiB;
constexpr int POW_L = 147456, BBAR_L = 32768, LAML_L = 2048;
constexpr size_t WO_GU1 = 0, WO_D1 = WO_GU1 + 5632u * 1024, WO_GU2 = WO_D1 + 1024u * 2816, WO_D2 = WO_GU2 + 5632u * 1024, WO_IN = WO_D2 + 1024u * 2816,
    WO_OUT = WO_IN + 3072u * 1024, WO_Q = WO_OUT + 1024u * 1024, WO_KV = WO_Q + 1024u * 1024, WO_O = WO_KV + 2048u * 1024, WO_GLU = WO_O + 1024u * 1024,
    WO_END = WO_GLU + 256u * 256;
static_assert(WO_END * 2 <= 52 * MiB, "weights fit");
constexpr size_t OUT_VT = 0, OUT_C = 64 * MiB, OUT_SUX = 128 * MiB, OUT_YS5 = 164 * MiB;
constexpr size_t WS_RSTAT = 1007 * MiB, WS_RSTID = 1007 * MiB + 512 * 1024, WS_ONES = 1008 * MiB, WS_ZEROS = 1008 * MiB + 4096;
constexpr size_t WS_CC = 65536, CC_L = 30720;
constexpr int CC_GU1 = 0, CC_IN = 5632, CC_Q = 8704, CC_GU2 = 9728, CC_N = 15360;
constexpr size_t WS_STATP = 128 * MiB;
constexpr int LDS_BYTES = 147456;

struct Args { const float* in[28]; float* out; unsigned char* ws; };
typedef const __attribute__((address_space(4))) Args CArgs;
__device__ __forceinline__ CArgs* kargs() { CArgs* p = (CArgs*)__builtin_amdgcn_kernarg_segment_ptr(); asm volatile("" : "+s"(p)); return p; }

__device__ __forceinline__ unsigned pkbf(float lo, float hi) { return pg8::cvt_pk_bf16(lo, hi); }
__device__ __forceinline__ float bf2f(unsigned short b) { return __uint_as_float(((unsigned)b) << 16); }
__device__ __forceinline__ float bflo(unsigned w) { return __uint_as_float(w << 16); }
__device__ __forceinline__ float bfhi(unsigned w) { return __uint_as_float(w & 0xffff0000u); }
typedef _Float16 h16x2 __attribute__((ext_vector_type(2)));
__device__ __forceinline__ unsigned pkh(float lo, float hi) { h16x2 v; v.x = (_Float16)lo; v.y = (_Float16)hi; return __builtin_bit_cast(unsigned, v); }
__device__ __forceinline__ float hlo(unsigned w) { return (float)__builtin_bit_cast(h16x2, w).x; }
__device__ __forceinline__ float hhi(unsigned w) { return (float)__builtin_bit_cast(h16x2, w).y; }
__device__ __forceinline__ float wave_sum(float v) {
#pragma unroll
    for (int o = 1; o < 64; o <<= 1) v += __shfl_xor(v, o);
    return v;
}
__device__ __forceinline__ float wave_max(float v) {
#pragma unroll
    for (int o = 1; o < 64; o <<= 1) v = fmaxf(v, __shfl_xor(v, o));
    return v;
}
__device__ __forceinline__ float sigmoidf_(float x) { return __builtin_amdgcn_rcpf(1.f + __expf(-x)); }
__device__ __forceinline__ float siluf_(float x) { return x * sigmoidf_(x); }
__device__ __forceinline__ float gelu_tanh(float x) { const float u = x * (1.5957691216057308f + 0.07135481627f * x * x); return x * __builtin_amdgcn_rcpf(1.f + __expf(-u)); }
#define LDS_WAIT() asm volatile("s_waitcnt lgkmcnt(0)" ::: "memory")

__device__ __forceinline__ void sincos_d(double x, double& s, double& c) {
    const double TWO_PI = 6.283185307179586476925286766559;
    const double n = rint(x / TWO_PI);
    const double r = x - n * TWO_PI, r2 = r * r;
    double ts = r, tc = 1.0; s = r; c = 1.0;
#pragma unroll 1
    for (int k = 1; k <= 16; ++k) { tc = -tc * r2 / (double)((2 * k - 1) * (2 * k)); c += tc; ts = -ts * r2 / (double)((2 * k) * (2 * k + 1)); s += ts; }
}

__device__ __forceinline__ void tr_block(const float* W, int ldw, int k0, int c0, bf16* WT, int ldt, int n0, LAS float* scr, int lane, bool fold, const float* gk, const float* bk, float* c1, float* c2, int nvalid) {
#pragma unroll 8
    for (int i = 0; i < 32; ++i) { const int kk = 2 * i + (lane >> 5); scr[kk * 33 + (lane & 31)] = W[(size_t)(k0 + kk) * ldw + c0 + (lane & 31)]; }
    LDS_WAIT(); asm volatile("" ::: "memory");
    const int c = lane & 7;
    if (!fold) {
#pragma unroll
        for (int j = 0; j < 4; ++j) { const int n = (lane >> 3) + 8 * j; const LAS float* s = scr + (8 * c) * 33 + n;
            v4u o; o.x = pkbf(s[0 * 33], s[1 * 33]); o.y = pkbf(s[2 * 33], s[3 * 33]); o.z = pkbf(s[4 * 33], s[5 * 33]); o.w = pkbf(s[6 * 33], s[7 * 33]);
            *(v4u*)(WT + (size_t)(n0 + n) * ldt + k0 + 8 * c) = o; }
    } else {
        float gv[8], bv[8];
#pragma unroll
        for (int i = 0; i < 8; ++i) { gv[i] = gk ? gk[k0 + 8 * c + i] : 1.f; bv[i] = bk ? bk[k0 + 8 * c + i] : 0.f; }
#pragma unroll
        for (int j = 0; j < 4; ++j) { const int n = (lane >> 3) + 8 * j; const LAS float* s = scr + (8 * c) * 33 + n; const float live = n < nvalid ? 1.f : 0.f;
            float w[8]; float p2 = 0.f;
#pragma unroll
            for (int i = 0; i < 8; ++i) { const float raw = s[i * 33] * live; w[i] = raw * gv[i]; p2 += raw * bv[i]; }
            v4u o; o.x = pkh(w[0], w[1]); o.y = pkh(w[2], w[3]); o.z = pkh(w[4], w[5]); o.w = pkh(w[6], w[7]);
            *(v4u*)(WT + (size_t)(n0 + n) * ldt + k0 + 8 * c) = o;
            float p1 = ((hlo(o.x) + hhi(o.x)) + (hlo(o.y) + hhi(o.y))) + ((hlo(o.z) + hhi(o.z)) + (hlo(o.w) + hhi(o.w)));
            p1 += __shfl_xor(p1, 1); p1 += __shfl_xor(p1, 2); p1 += __shfl_xor(p1, 4); p2 += __shfl_xor(p2, 1); p2 += __shfl_xor(p2, 2); p2 += __shfl_xor(p2, 4);
            if (c == 0) { atomicAdd(c1 + n0 + n, p1); atomicAdd(c2 + n0 + n, p2); } }
    }
    LDS_WAIT(); asm volatile("" ::: "memory");
}
__device__ __forceinline__ void tr_job(const float* W, const float* W2, int ldw, int K, int ndest, bf16* WT, int mode, LAS float* scr, int gw, int NGW, int lane,
                                       bool fold = false, const float* gk = nullptr, const float* bk = nullptr, float* c1 = nullptr, float* c2 = nullptr) {
    const int nb = ndest / 32, items = (K / 64) * nb;
    for (int it = gw; it < items; it += NGW) {
        const int kb = it / nb, n0 = (it % nb) * 32; const float* src = W; int c0 = n0, nvalid = 32;
        if (mode == 1) { const int pn = n0 >> 8, bj = (n0 >> 7) & 1, cc = n0 & 127; src = bj ? W2 : W; c0 = 128 * pn + cc; }
        else if (mode == 2) { if (n0 < 1024) { const int pn = n0 >> 8, half = (n0 >> 7) & 1, v = (n0 >> 5) & 3; c0 = 256 * pn + 64 * v + 32 * half; } else if (n0 >= 2816) { c0 = 2560; nvalid = n0 == 2816 ? 8 : 0; } else if (n0 >= 2560) c0 = n0 + 8; }
        tr_block(src, ldw, kb * 64, c0, WT, K, n0, scr, lane, fold, gk, bk, c1, c2, nvalid);
    }
}

__device__ __forceinline__ void layer_prep1(CArgs& A, LAS unsigned char* lds, int l) {
    l = lnd(l);
    const int tid = tidx(), lane = tid & 63, wave = tid >> 6, G = gdim(), bid = bidx();
    const int gw = bid * 8 + wave, NGW = G * 8, gt = bid * 512 + tid, NGT = G * 512;
    LAS float* scr = (LAS float*)(lds + wave * 16384);
    bf16* Wb = (bf16*)(A.ws + WS_W);
    const size_t f1 = (size_t)1024 * 2816;
    float* c1v = (float*)(A.ws + WS_CC) + (size_t)l * CC_L; float* c2v = c1v + CC_N;
    const float* lg = A.in[5] + l * 4096; const float* lb = A.in[6] + l * 4096;
    tr_job(A.in[2] + (size_t)(l * 2 + 0) * f1, A.in[3] + (size_t)(l * 2 + 0) * f1, 2816, 1024, 5632, Wb + WO_GU1, 1, scr, gw, NGW, lane, true, l ? lg - 1024 : nullptr, l ? lb - 1024 : nullptr, c1v + CC_GU1, c2v + CC_GU1);
    tr_job(A.in[2] + (size_t)(l * 2 + 1) * f1, A.in[3] + (size_t)(l * 2 + 1) * f1, 2816, 1024, 5632, Wb + WO_GU2, 1, scr, gw, NGW, lane, true, lg + 2048, lb + 2048, c1v + CC_GU2, c2v + CC_GU2);
    tr_job(A.in[4] + (size_t)(l * 2 + 0) * f1, nullptr, 1024, 2816, 1024, Wb + WO_D1, 0, scr, gw, NGW, lane);
    tr_job(A.in[4] + (size_t)(l * 2 + 1) * f1, nullptr, 1024, 2816, 1024, Wb + WO_D2, 0, scr, gw, NGW, lane);
    tr_job(A.in[7] + (size_t)l * 1024 * DINW, nullptr, DINW, 1024, 3072, Wb + WO_IN, 2, scr, gw, NGW, lane, true, lg, lb, c1v + CC_IN, c2v + CC_IN);
    tr_job(A.in[24] + (size_t)l * 1024 * 1024, nullptr, 1024, 1024, 1024, Wb + WO_OUT, 0, scr, gw, NGW, lane);
    tr_job(A.in[25] + (size_t)l * 1024 * 1024, nullptr, 1024, 1024, 1024, Wb + WO_Q, 0, scr, gw, NGW, lane, true, lg + 1024, lb + 1024, c1v + CC_Q, c2v + CC_Q);
    tr_job(A.in[26] + (size_t)l * 1024 * 2048, nullptr, 2048, 1024, 2048, Wb + WO_KV, 0, scr, gw, NGW, lane);
    tr_job(A.in[27] + (size_t)l * 1024 * 1024, nullptr, 1024, 1024, 1024, Wb + WO_O, 0, scr, gw, NGW, lane);
    tr_job(A.in[22] + (size_t)l * 256 * 256, nullptr, 256, 256, 256, Wb + WO_GLU, 0, scr, gw, NGW, lane);
}
__device__ __forceinline__ void prep0(CArgs& A) {
    const int tid = tidx(), G = gdim(), bid = bidx(); const int gt = bid * 512 + tid, NGT = G * 512;
    for (int l = 0; l < 2; ++l) {
    { float* POW = (float*)(A.ws + WS_POW) + l * POW_L; float* BBAR = (float*)(A.ws + WS_BBAR) + l * BBAR_L; float* LAML = (float*)(A.ws + WS_LAML) + l * LAML_L;
      const float* are = A.in[14] + l * 1024; const float* aim = A.in[15] + l * 1024; const float* lst = A.in[16] + l * 16;
      const float* bre = A.in[17] + (size_t)l * 16384; const float* bim = A.in[18] + (size_t)l * 16384;
      for (int i = gt; i < 16 * 65 * 64; i += NGT) { const int g = i / (65 * 64), tau = (i >> 6) % 65, p = i & 63;
          const double step = exp((double)lst[g]); const double ar = (double)are[g * 64 + p], ai = (double)aim[g * 64 + p];
          const double mag = exp((double)tau * ar * step); double s, c; sincos_d((double)tau * ai * step, s, c);
          POW[2 * i] = (float)(mag * c); POW[2 * i + 1] = (float)(mag * s);
          if (tau == 64) { LAML[2 * (g * 64 + p)] = (float)(mag * c); LAML[2 * (g * 64 + p) + 1] = (float)(mag * s); } }
      for (int i = gt; i < 16 * 64 * 16; i += NGT) { const int g = i >> 10, p = (i >> 4) & 63;
          const double step = exp((double)lst[g]); const double ar = (double)are[g * 64 + p], ai = (double)aim[g * 64 + p];
          const double mag = exp(ar * step); double s, c; sincos_d(ai * step, s, c);
          const double lr = mag * c - 1.0, li = mag * s, den = ar * ar + ai * ai;
          const double zr = (lr * ar + li * ai) / den, zi = (li * ar - lr * ai) / den;
          const double br = (double)bre[i], bi = (double)bim[i];
          BBAR[2 * i] = (float)(zr * br - zi * bi); BBAR[2 * i + 1] = (float)(zr * bi + zi * br); } }
    }
    {
        float* RC = (float*)(A.ws + WS_ROPE); float* RS = RC + 4096 * 32;
        for (int i = gt; i < 4096 * 32; i += NGT) { const int pos = i >> 5, k = i & 31;
            const float inv = (float)exp(-(double)(2 * k) / 64.0 * 9.210340371976184); const float ang = (float)pos * inv;
            double s, c; sincos_d((double)ang, s, c); RC[i] = (float)c; RS[i] = (float)s; }
        { float* rid = (float*)(A.ws + WS_RSTID); for (int i = gt; i < 2 * MT; i += NGT) rid[i] = (i & 1) ? 1.f : 0.f;
          float* on = (float*)(A.ws + WS_ONES); float* ze = (float*)(A.ws + WS_ZEROS); for (int i = gt; i < 1024; i += NGT) { on[i] = 1.f; ze[i] = 0.f; } }
        { const f32x4* x4 = (const f32x4*)A.in[0]; v2u* oh = (v2u*)(A.ws + WS_Y);
          for (size_t i = gt; i < (size_t)MT * DM / 4; i += NGT) { const f32x4 v = x4[i]; v2u h; h.x = pkh(v.x, v.y); h.y = pkh(v.z, v.w); oh[i] = h; } }
        { const f32x4* x4 = (const f32x4*)A.in[1]; v2u* o = (v2u*)(A.ws + WS_MEMB);
          for (size_t i = gt; i < (size_t)4096 * DM / 4; i += NGT) { const f32x4 v = x4[i]; v2u w; w.x = pkbf(v.x, v.y); w.y = pkbf(v.z, v.w); o[i] = w; } }
    }
}
__device__ __forceinline__ void s5_ktab(CArgs& A, int l) {
    l = lnd(l);
    const int gt = bidx() * 512 + tidx(), NGT = gdim() * 512;
    const float* POW = (const float*)(A.ws + WS_POW) + l * POW_L; const float* BBAR = (const float*)(A.ws + WS_BBAR) + l * BBAR_L; float* KT = (float*)(A.ws + WS_KTAB);
    const float* cre = A.in[19] + (size_t)l * 16384; const float* cim = A.in[20] + (size_t)l * 16384;
    for (int i = gt; i < 16 * 64 * 256; i += NGT) { const int g = i >> 14, tau = (i >> 8) & 63, co = (i >> 4) & 15, ci = i & 15; float acc = 0.f;
        for (int p = 0; p < 64; ++p) { const float cr = cre[(g * 16 + co) * 64 + p], cm = cim[(g * 16 + co) * 64 + p];
            const f32x2 P = *(const f32x2*)(POW + 2 * ((g * 65 + tau) * 64 + p)); const f32x2 B = *(const f32x2*)(BBAR + 2 * ((g * 64 + p) * 16 + ci));
            const float zr = P.x * B.x - P.y * B.y, zi = P.x * B.y + P.y * B.x; acc += cr * zr - cm * zi; }
        KT[i] = acc; }
}
__device__ __forceinline__ void s5_fill(CArgs& A, int l) {
    l = lnd(l);
    const int gt = bidx() * 512 + tidx(), NGT = gdim() * 512;
    const float* POW = (const float*)(A.ws + WS_POW) + l * POW_L; const float* BBAR = (const float*)(A.ws + WS_BBAR) + l * BBAR_L; const float* KT = (const float*)(A.ws + WS_KTAB);
    const float* cre = A.in[19] + (size_t)l * 16384; const float* cim = A.in[20] + (size_t)l * 16384; const float* Dk = A.in[21] + l * 256;
    bf16* TF = (bf16*)(A.ws + WS_TF); bf16* EM = (bf16*)(A.ws + WS_EM);
    for (int i = gt; i < 16384 * 144; i += NGT) { const int row = i / 144, k8 = i % 144, g = row >> 10, t = (row >> 4) & 63, co = row & 15; float v[8];
        if (k8 < 128) { const int s = k8 >> 1, ci0 = (k8 & 1) * 8;
#pragma unroll
            for (int j = 0; j < 8; ++j) { const int ci = ci0 + j; float x = 0.f; if (s <= t) { x = KT[((g * 64 + (t - s)) * 16 + co) * 16 + ci]; if (s == t && ci == co) x += Dk[g * 16 + co]; } v[j] = x; } }
        else {
#pragma unroll
            for (int j = 0; j < 8; ++j) { const int q = (k8 - 128) * 8 + j, p = q >> 1, ri = q & 1; const float cr = cre[(g * 16 + co) * 64 + p], cm = cim[(g * 16 + co) * 64 + p];
                const f32x2 P = *(const f32x2*)(POW + 2 * ((g * 65 + t + 1) * 64 + p)); v[j] = ri ? -(cr * P.y + cm * P.x) : (cr * P.x - cm * P.y); } }
        v4u o; o.x = pkbf(v[0], v[1]); o.y = pkbf(v[2], v[3]); o.z = pkbf(v[4], v[5]); o.w = pkbf(v[6], v[7]);
        *(v4u*)(TF + (size_t)row * 1152 + k8 * 8) = o; }
    for (int i = gt; i < 4096 * 128; i += NGT) { const int row = i >> 7, k8 = i & 127, g = row >> 8, n_ = row & 255, s = k8 >> 1, ci0 = (k8 & 1) * 8; float v[8];
#pragma unroll
        for (int j = 0; j < 8; ++j) { float x = 0.f; if (n_ < 128) { const int p = n_ >> 1, ri = n_ & 1; const f32x2 P = *(const f32x2*)(POW + 2 * ((g * 65 + (63 - s)) * 64 + p));
                const f32x2 B = *(const f32x2*)(BBAR + 2 * ((g * 64 + p) * 16 + ci0 + j)); x = ri ? (P.x * B.y + P.y * B.x) : (P.x * B.x - P.y * B.y); } v[j] = x; }
        v4u o; o.x = pkbf(v[0], v[1]); o.y = pkbf(v[2], v[3]); o.z = pkbf(v[4], v[5]); o.w = pkbf(v[6], v[7]);
        *(v4u*)(EM + (size_t)row * 1024 + k8 * 8) = o; }
}

__device__ __forceinline__ void ln_phase(const bf16* YB, const float* gam, const float* bet, float* X, bf16* XB, const float* WG, float* GATES, float* RST) {
    const int tid = tidx(), lane = tid & 63, wave = tid >> 6; const int gw = bidx() * 8 + wave, NGW = gdim() * 8;
    f32x4 gg[2][2], bb[2][2];
#pragma unroll
    for (int j = 0; j < 2; ++j)
#pragma unroll
        for (int q = 0; q < 2; ++q) { gg[j][q] = *(const f32x4*)(gam + lane * 8 + 512 * j + 4 * q); bb[j][q] = *(const f32x4*)(bet + lane * 8 + 512 * j + 4 * q); }
    for (int row0 = gw * 4; row0 < MT; row0 += NGW * 4) {
        v4u raw[4][2];
#pragma unroll
        for (int r = 0; r < 4; ++r)
#pragma unroll
            for (int j = 0; j < 2; ++j) raw[r][j] = *(const v4u*)(YB + (size_t)(row0 + r) * DM + lane * 8 + 512 * j);
        __builtin_amdgcn_sched_barrier(0);
#pragma unroll
        for (int r = 0; r < 4; ++r) { const int row = row0 + r; f32x4 v[2][2]; float s = 0.f;
#pragma unroll
            for (int j = 0; j < 2; ++j) { v[j][0] = (f32x4){hlo(raw[r][j].x), hhi(raw[r][j].x), hlo(raw[r][j].y), hhi(raw[r][j].y)}; v[j][1] = (f32x4){hlo(raw[r][j].z), hhi(raw[r][j].z), hlo(raw[r][j].w), hhi(raw[r][j].w)};
                s += ((v[j][0].x + v[j][0].y) + (v[j][0].z + v[j][0].w)) + ((v[j][1].x + v[j][1].y) + (v[j][1].z + v[j][1].w)); }
            const float mean = wave_sum(s) * (1.f / DM); float s2 = 0.f;
#pragma unroll
            for (int j = 0; j < 2; ++j)
#pragma unroll
                for (int q = 0; q < 2; ++q) { v[j][q] = v[j][q] - mean; s2 += (v[j][q].x * v[j][q].x + v[j][q].y * v[j][q].y) + (v[j][q].z * v[j][q].z + v[j][q].w * v[j][q].w); }
            const float rstd = 1.f / sqrtf(wave_sum(s2) * (1.f / DM) + EPS);
            if (lane == 0) *(f32x2*)(RST + 2 * (size_t)row) = (f32x2){mean, rstd};
#pragma unroll
            for (int j = 0; j < 2; ++j) { v[j][0] = v[j][0] * rstd * gg[j][0] + bb[j][0]; v[j][1] = v[j][1] * rstd * gg[j][1] + bb[j][1];
                v4u w; w.x = pkbf(v[j][0].x, v[j][0].y); w.y = pkbf(v[j][0].z, v[j][0].w); w.z = pkbf(v[j][1].x, v[j][1].y); w.w = pkbf(v[j][1].z, v[j][1].w);
                if (XB) *(v4u*)(XB + (size_t)row * DM + lane * 8 + 512 * j) = w; }
            if (X) {
#pragma unroll
                for (int j = 0; j < 2; ++j) { *(f32x4*)(X + (size_t)row * DM + lane * 8 + 512 * j) = v[j][0]; *(f32x4*)(X + (size_t)row * DM + lane * 8 + 512 * j + 4) = v[j][1]; } }
            if (WG) { float mine = 0.f;
#pragma unroll
                for (int gc = 0; gc < 8; ++gc) { float p = 0.f;
#pragma unroll
                    for (int j = 0; j < 2; ++j)
#pragma unroll
                        for (int q = 0; q < 2; ++q) { const f32x4 w = *(const f32x4*)(WG + gc * 1024 + lane * 8 + 512 * j + 4 * q); p += (v[j][q].x * w.x + v[j][q].y * w.y) + (v[j][q].z * w.z + v[j][q].w * w.w); }
                    p = wave_sum(p); if (lane == gc) mine = p; }
                if (lane < 8) GATES[(size_t)row * 8 + lane] = mine; }
        }
    }
}

__device__ __forceinline__ void stat_finalize(const float* SP, float* RST) {
    const int gt = bidx() * 512 + tidx(), NGT = gdim() * 512;
    for (int row = gt; row < MT; row += NGT) { const f32x4* p = (const f32x4*)(SP + (size_t)row * 32); float sm = 0.f, sq = 0.f;
#pragma unroll
        for (int i = 0; i < 8; ++i) { const f32x4 v = p[i]; sm += v.x + v.z; sq += v.y + v.w; }
        const float mean = sm * (1.f / DM), var = fmaxf(sq * (1.f / DM) - mean * mean, 0.f); *(f32x2*)(RST + 2 * (size_t)row) = (f32x2){mean, 1.f / sqrtf(var + EPS)}; }
}

#define EPI_ARGS const f32x4 (&acc)[2][2][4][2], const Unit& u, int wr, int wc, int fr, int fq
#define EPI_IDS() do { const int t_ = tidx(); fr = t_ & 15; fq = (t_ >> 4) & 3; wc = (t_ >> 6) & 3; wr = t_ >> 8; } while (0)
struct LnFold { const float* rst; const float* c1; const float* c2;
    __device__ __forceinline__ f32x4 fix(const f32x4& a, const f32x2& ms, int nrow) const { const f32x4 u = *(const f32x4*)(c1 + nrow), v = *(const f32x4*)(c2 + nrow); return (a - u * ms.x) * ms.y + v; }
    __device__ __forceinline__ void load(int nbase, int row0, f32x4 (&u1)[2][2], f32x4 (&u2)[2][2], f32x2 (&ms)[2][4]) const {
#pragma unroll
        for (int bj = 0; bj < 2; ++bj)
#pragma unroll
            for (int n = 0; n < 2; ++n) { u1[bj][n] = *(const f32x4*)(c1 + nbase + bj * 128 + n * 16); u2[bj][n] = *(const f32x4*)(c2 + nbase + bj * 128 + n * 16); }
#pragma unroll
        for (int ai = 0; ai < 2; ++ai)
#pragma unroll
            for (int m = 0; m < 4; ++m) ms[ai][m] = *(const f32x2*)(rst + 2 * (size_t)(row0 + ai * 128 + m * 16));
    }
    static __device__ __forceinline__ f32x4 app(const f32x4& a, const f32x4& u, const f32x4& v, const f32x2& ms) { return (a - u * ms.x) * ms.y + v; }
};
struct EpiSwiGLU { static constexpr bool PERM = true, AFTER_DRAIN = false; bf16* H; LnFold F;
    __device__ __forceinline__ void operator()(EPI_ARGS) const { EPI_IDS();
        const int row0 = u.pm * 256 + wr * 64 + fr, col0 = u.pn * 128 + wc * 32 + 8 * fq, nb = u.pn * 256 + wc * 32 + 8 * fq;
        f32x4 u1[2][2], u2[2][2]; f32x2 msa[2][4];
#pragma unroll
        for (int bj = 0; bj < 2; ++bj)
#pragma unroll
            for (int n = 0; n < 2; ++n) { u1[bj][n] = *(const f32x4*)(F.c1 + nb + bj * 128 + n * 4); u2[bj][n] = *(const f32x4*)(F.c2 + nb + bj * 128 + n * 4); }
#pragma unroll
        for (int ai = 0; ai < 2; ++ai)
#pragma unroll
            for (int m = 0; m < 4; ++m) msa[ai][m] = *(const f32x2*)(F.rst + 2 * (size_t)(row0 + ai * 128 + m * 16));
#pragma unroll
        for (int ai = 0; ai < 2; ++ai)
#pragma unroll
            for (int m = 0; m < 4; ++m) { const int r = row0 + ai * 128 + m * 16; const f32x2 ms = msa[ai][m]; v4u w;
                { const f32x4 g = LnFold::app(acc[ai][0][m][0], u1[0][0], u2[0][0], ms), up = LnFold::app(acc[ai][1][m][0], u1[1][0], u2[1][0], ms);
                  w.x = pkbf(siluf_(g[0]) * up[0], siluf_(g[1]) * up[1]); w.y = pkbf(siluf_(g[2]) * up[2], siluf_(g[3]) * up[3]); }
                { const f32x4 g = LnFold::app(acc[ai][0][m][1], u1[0][1], u2[0][1], ms), up = LnFold::app(acc[ai][1][m][1], u1[1][1], u2[1][1], ms);
                  w.z = pkbf(siluf_(g[0]) * up[0], siluf_(g[1]) * up[1]); w.w = pkbf(siluf_(g[2]) * up[2], siluf_(g[3]) * up[3]); }
                *(v4u*)(H + (size_t)r * DFF + col0) = w; }
    }
};
struct EpiResid { static constexpr bool PERM = false, AFTER_DRAIN = false; const bf16* Xr; bf16* Y; float s; const float* rst; const float* gam; const float* bet; float* sp;
    __device__ __forceinline__ void operator()(EPI_ARGS) const { EPI_IDS();
        const int row0 = u.pm * 256 + wr * 64 + fr, col0 = u.pn * 256 + wc * 32 + 4 * fq;
        f32x4 gg[2][2], bb[2][2];
#pragma unroll
        for (int bj = 0; bj < 2; ++bj)
#pragma unroll
            for (int n = 0; n < 2; ++n) { gg[bj][n] = *(const f32x4*)(gam + col0 + bj * 128 + n * 16) * ALPHA; bb[bj][n] = *(const f32x4*)(bet + col0 + bj * 128 + n * 16) * ALPHA; }
#pragma unroll
        for (int ai = 0; ai < 2; ++ai) {
            v2u x[4][2][2]; f32x2 ms[4];
#pragma unroll
            for (int m = 0; m < 4; ++m) { const int r = row0 + ai * 128 + m * 16; const size_t off = (size_t)r * DM + col0; ms[m] = *(const f32x2*)(rst + 2 * (size_t)r);
#pragma unroll
                for (int bj = 0; bj < 2; ++bj)
#pragma unroll
                    for (int n = 0; n < 2; ++n) x[m][bj][n] = *(const v2u*)(Xr + off + bj * 128 + n * 16); }
            __builtin_amdgcn_sched_barrier(0);
#pragma unroll
            for (int m = 0; m < 4; ++m) { const int r = row0 + ai * 128 + m * 16; const size_t off = (size_t)r * DM + col0; float sm = 0.f, sq = 0.f;
#pragma unroll
                for (int bj = 0; bj < 2; ++bj)
#pragma unroll
                    for (int n = 0; n < 2; ++n) { const f32x4 xv = (f32x4){hlo(x[m][bj][n].x), hhi(x[m][bj][n].x), hlo(x[m][bj][n].y), hhi(x[m][bj][n].y)};
                        const f32x4 y = ((xv - ms[m].x) * ms[m].y) * gg[bj][n] + bb[bj][n] + acc[ai][bj][m][n] * s; v2u w; w.x = pkh(y[0], y[1]); w.y = pkh(y[2], y[3]);
                        *(v2u*)(Y + off + bj * 128 + n * 16) = w;
                        const float y0 = hlo(w.x), y1 = hhi(w.x), y2 = hlo(w.y), y3 = hhi(w.y); sm += (y0 + y1) + (y2 + y3); sq += (y0 * y0 + y1 * y1) + (y2 * y2 + y3 * y3); }
                sm += __shfl_xor(sm, 16); sm += __shfl_xor(sm, 32); sq += __shfl_xor(sq, 16); sq += __shfl_xor(sq, 32);
                if (fq == 0) *(f32x2*)(sp + ((size_t)r * 16 + u.pn * 4 + wc) * 2) = (f32x2){sm, sq}; }
            __builtin_amdgcn_sched_barrier(0);
        }
    }
};
struct EpiBf16 { static constexpr bool PERM = false, AFTER_DRAIN = false; static constexpr int ld = DM; static constexpr float s = 0.0625f * LOG2E; bf16* O; LnFold F;
    __device__ __forceinline__ void operator()(EPI_ARGS) const { EPI_IDS();
        const int row0 = u.pm * 256 + wr * 64 + fr, col0 = u.pn * 256 + wc * 32 + 4 * fq;
        f32x4 u1[2][2], u2[2][2]; f32x2 msa[2][4]; F.load(col0, row0, u1, u2, msa);
#pragma unroll
        for (int ai = 0; ai < 2; ++ai)
#pragma unroll
            for (int m = 0; m < 4; ++m) { const int r = row0 + ai * 128 + m * 16; bf16* rp = O + (size_t)r * ld + col0; const f32x2 ms = msa[ai][m];
#pragma unroll
                for (int bj = 0; bj < 2; ++bj)
#pragma unroll
                    for (int n = 0; n < 2; ++n) { const f32x4 v = LnFold::app(acc[ai][bj][m][n], u1[bj][n], u2[bj][n], ms) * s; v2u w; w.x = pkbf(v[0], v[1]); w.y = pkbf(v[2], v[3]); *(v2u*)(rp + bj * 128 + n * 16) = w; } }
    }
};
struct EpiProj { static constexpr bool PERM = false, AFTER_DRAIN = false; bf16* P; bf16* VT; bf16* SUX; const float* RC; const float* RS; LnFold F; float* GATES;
    __device__ __forceinline__ void operator()(EPI_ARGS) const { EPI_IDS();
        const int row0 = u.pm * 256 + wr * 64 + fr; const int pn = u.pn;
        f32x4 u1[2][2], u2[2][2]; f32x2 msa[2][4]; F.load(pn * 256 + wc * 32 + 4 * fq, row0, u1, u2, msa);
        if (pn < 4) { const float sc = pn < 2 ? 0.125f * LOG2E : 1.f;
#pragma unroll
            for (int ai = 0; ai < 2; ++ai)
#pragma unroll
                for (int m = 0; m < 4; ++m) { const int r = row0 + ai * 128 + m * 16, pos = r & 4095; bf16* rp = P + (size_t)r * NPJ + pn * 256 + wc * 64 + 4 * fq; const f32x2 ms = msa[ai][m];
#pragma unroll
                    for (int n = 0; n < 2; ++n) { const f32x4 c = *(const f32x4*)(RC + pos * 32 + n * 16 + 4 * fq), s = *(const f32x4*)(RS + pos * 32 + n * 16 + 4 * fq);
                        const f32x4 t1 = LnFold::app(acc[ai][0][m][n], u1[0][n], u2[0][n], ms), t2 = LnFold::app(acc[ai][1][m][n], u1[1][n], u2[1][n], ms); const f32x4 o1 = (t1 * c - t2 * s) * sc, o2 = (t2 * c + t1 * s) * sc; v2u w;
                        w.x = pkbf(o1[0], o1[1]); w.y = pkbf(o1[2], o1[3]); *(v2u*)(rp + n * 16) = w; w.x = pkbf(o2[0], o2[1]); w.y = pkbf(o2[2], o2[3]); *(v2u*)(rp + 32 + n * 16) = w; } }
        } else if (pn < 6) {
#pragma unroll
            for (int ai = 0; ai < 2; ++ai)
#pragma unroll
                for (int m = 0; m < 4; ++m) { const int r = row0 + ai * 128 + m * 16, b = r >> 12, sp = r & 4095; const f32x2 ms = msa[ai][m];
#pragma unroll
                    for (int bj = 0; bj < 2; ++bj) { const int h = 2 * (pn - 4) + bj; bf16* vp = VT + ((size_t)((b * 4 + h) * 128 + wc * 32 + 4 * fq)) * 4096 + sp;
#pragma unroll
                        for (int n = 0; n < 2; ++n) { const f32x4 v = LnFold::app(acc[ai][bj][m][n], u1[bj][n], u2[bj][n], ms); const unsigned w0 = pkbf(v[0], v[1]), w1 = pkbf(v[2], v[3]);
                            vp[(size_t)(n * 16 + 0) * 4096] = (bf16)(w0 & 0xffff); vp[(size_t)(n * 16 + 1) * 4096] = (bf16)(w0 >> 16);
                            vp[(size_t)(n * 16 + 2) * 4096] = (bf16)(w1 & 0xffff); vp[(size_t)(n * 16 + 3) * 4096] = (bf16)(w1 >> 16); } } }
        } else if (pn < 10) {
#pragma unroll
            for (int ai = 0; ai < 2; ++ai)
#pragma unroll
                for (int m = 0; m < 4; ++m) { const int r = row0 + ai * 128 + m * 16; bf16* rp = P + (size_t)r * NPJ + pn * 256 + wc * 32 + 4 * fq; const f32x2 ms = msa[ai][m];
#pragma unroll
                    for (int bj = 0; bj < 2; ++bj)
#pragma unroll
                        for (int n = 0; n < 2; ++n) { const f32x4 v = LnFold::app(acc[ai][bj][m][n], u1[bj][n], u2[bj][n], ms); v2u w; w.x = pkbf(v[0], v[1]); w.y = pkbf(v[2], v[3]); *(v2u*)(rp + bj * 128 + n * 16) = w; } }
        } else if (pn == 11) {
            if (wc == 0 && fq < 2) {
#pragma unroll
                for (int ai = 0; ai < 2; ++ai)
#pragma unroll
                    for (int m = 0; m < 4; ++m) { const int r = row0 + ai * 128 + m * 16; const f32x2 ms = msa[ai][m];
                        *(f32x4*)(GATES + (size_t)r * 8 + 4 * fq) = LnFold::app(acc[ai][0][m][0], u1[0][0], u2[0][0], ms); } }
        } else {
#pragma unroll
            for (int ai = 0; ai < 2; ++ai)
#pragma unroll
                for (int m = 0; m < 4; ++m) { const int r = row0 + ai * 128 + m * 16, mch = r >> 6, t = r & 63; const f32x2 ms = msa[ai][m];
#pragma unroll
                    for (int bj = 0; bj < 2; ++bj)
#pragma unroll
                        for (int n = 0; n < 2; ++n) { const int g = 8 * bj + 2 * wc + n; const f32x4 v = LnFold::app(acc[ai][bj][m][n], u1[bj][n], u2[bj][n], ms); v2u w; w.x = pkbf(v[0], v[1]); w.y = pkbf(v[2], v[3]);
                            *(v2u*)(SUX + ((size_t)g * 1024 + mch) * 1152 + t * 16 + 4 * fq) = w; } }
        }
    }
};
struct EpiKV { static constexpr bool PERM = false, AFTER_DRAIN = false; bf16* KX; bf16* VTX;
    __device__ __forceinline__ void operator()(EPI_ARGS) const { EPI_IDS();
        const int row0 = u.pm * 256 + wr * 64 + fr; const int pn = u.pn;
        if (pn < 4) {
#pragma unroll
            for (int ai = 0; ai < 2; ++ai)
#pragma unroll
                for (int m = 0; m < 4; ++m) { bf16* rp = KX + (size_t)(row0 + ai * 128 + m * 16) * 1024 + pn * 256 + wc * 32 + 4 * fq;
#pragma unroll
                    for (int bj = 0; bj < 2; ++bj)
#pragma unroll
                        for (int n = 0; n < 2; ++n) { const f32x4 v = acc[ai][bj][m][n]; v2u w; w.x = pkbf(v[0], v[1]); w.y = pkbf(v[2], v[3]); *(v2u*)(rp + bj * 128 + n * 16) = w; } }
        } else { const int h = pn - 4;
#pragma unroll
            for (int ai = 0; ai < 2; ++ai)
#pragma unroll
                for (int m = 0; m < 4; ++m) { const int r = row0 + ai * 128 + m * 16, b = r >> 8, sp = r & 255;
#pragma unroll
                    for (int bj = 0; bj < 2; ++bj) { bf16* vp = VTX + ((size_t)((b * 4 + h) * 256 + bj * 128 + wc * 32 + 4 * fq)) * 256 + sp;
#pragma unroll
                        for (int n = 0; n < 2; ++n) { const f32x4 v = acc[ai][bj][m][n]; const unsigned w0 = pkbf(v[0], v[1]), w1 = pkbf(v[2], v[3]);
                            vp[(n * 16 + 0) * 256] = (bf16)(w0 & 0xffff); vp[(n * 16 + 1) * 256] = (bf16)(w0 >> 16);
                            vp[(n * 16 + 2) * 256] = (bf16)(w1 & 0xffff); vp[(n * 16 + 3) * 256] = (bf16)(w1 >> 16); } } }
        }
    }
};
struct EpiS5E { static constexpr bool PERM = false, AFTER_DRAIN = false; float* E;
    __device__ __forceinline__ void operator()(EPI_ARGS) const { EPI_IDS();
        const int row0 = u.pm * 256 + wr * 64 + fr;
#pragma unroll
        for (int ai = 0; ai < 2; ++ai)
#pragma unroll
            for (int m = 0; m < 4; ++m) { float* rp = E + (size_t)(row0 + ai * 128 + m * 16) * 128 + wc * 32 + 4 * fq;
#pragma unroll
                for (int n = 0; n < 2; ++n) *(f32x4*)(rp + n * 16) = acc[ai][0][m][n]; }
    }
};
struct EpiS5Y { static constexpr bool PERM = false, AFTER_DRAIN = false; bf16* Yo;
    __device__ __forceinline__ void operator()(EPI_ARGS) const { EPI_IDS();
        const int row0 = u.pm * 256 + wr * 64 + fr; const int pnl = u.pn & 3;
#pragma unroll
        for (int ai = 0; ai < 2; ++ai)
#pragma unroll
            for (int m = 0; m < 4; ++m) { const int R = row0 + ai * 128 + m * 16, g = R >> 10, mch = R & 1023;
#pragma unroll
                for (int bj = 0; bj < 2; ++bj)
#pragma unroll
                    for (int n = 0; n < 2; ++n) { const int t = pnl * 16 + bj * 8 + wc * 2 + n; const f32x4 v = acc[ai][bj][m][n]; v2u w;
                        w.x = pkbf(gelu_tanh(v[0]), gelu_tanh(v[1])); w.y = pkbf(gelu_tanh(v[2]), gelu_tanh(v[3]));
                        *(v2u*)(Yo + ((size_t)mch * 64 + t) * 256 + g * 16 + 4 * fq) = w; asm volatile("" ::: "memory"); } }
    }
};
struct EpiGLU { static constexpr bool PERM = false, AFTER_DRAIN = false; const bf16* Ys; const float* gb; bf16* CAT;
    __device__ __forceinline__ void operator()(EPI_ARGS) const { EPI_IDS();
        const int row0 = u.pm * 256 + wr * 64 + fr, col0 = wc * 32 + 4 * fq;
#pragma unroll
        for (int ai = 0; ai < 2; ++ai)
#pragma unroll
            for (int m = 0; m < 4; ++m) { const size_t r = (size_t)(row0 + ai * 128 + m * 16);
#pragma unroll
                for (int bj = 0; bj < 2; ++bj)
#pragma unroll
                    for (int n = 0; n < 2; ++n) { const int c = col0 + bj * 128 + n * 16; const f32x4 b = *(const f32x4*)(gb + c); const v2u yw = *(const v2u*)(Ys + r * 256 + c);
                        const f32x4 v = acc[ai][bj][m][n] + b; v2u w;
                        w.x = pkbf(bflo(yw.x) * sigmoidf_(v[0]), bfhi(yw.x) * sigmoidf_(v[1])); w.y = pkbf(bflo(yw.y) * sigmoidf_(v[2]), bfhi(yw.y) * sigmoidf_(v[3]));
                        *(v2u*)(CAT + r * DM + 768 + c) = w; asm volatile("" ::: "memory"); } }
    }
};
struct GroupOrder { int nwg, G, c, npm, npn;
    __device__ __forceinline__ void init(int ngroups, int npm_, int npn_, int G_, int c_) { npm = npm_; npn = npn_; nwg = ngroups * npm_ * npn_; G = G_; c = c_; }
    __device__ __forceinline__ bool next(int i, Unit& u) const { const int L = i * G + c; if (L >= nwg) return false; const int per = npm * npn, g = L / per, r = L % per; u.pm = g * npm + r % npm; u.pn = g * npn + r / npm; return true; }
    __device__ __forceinline__ void a_ready(const Unit&) const {}
    __device__ __forceinline__ void done(const Unit&) const {}
};
template <class Epi, bool F16 = false> __device__ __forceinline__ void run_gemm(LAS unsigned char* lds, const bf16* Ap, const bf16* Bt, int M, int N, int K, int lda, int ldb, const Epi& E) {
    pg8::Gemm g{Ap, Bt, M, N, K, lda, ldb}; pg8::StaticOrder S; S.init(M, N, gdim(), bidx());
    pg8::gemm_phase<Epi, pg8::StaticOrder, true, true, F16>(lds, g, S, E);
}

__device__ __forceinline__ float qmax4(float m) {
    auto r = __builtin_amdgcn_permlane32_swap(__float_as_uint(m), __float_as_uint(m), false, false); m = fmaxf(__uint_as_float(r[0]), __uint_as_float(r[1]));
    auto q = __builtin_amdgcn_permlane16_swap(__float_as_uint(m), __float_as_uint(m), false, false); return fmaxf(__uint_as_float(q[0]), __uint_as_float(q[1]));
}
template <int NMAP, int DQK, int DV>
__device__ __forceinline__ void attn_qks(LAS unsigned char* cur, int qi, int g, const bf16x8 (&qf)[NMAP][DQK / 32], f32x4 (&O)[NMAP][DV / 16], float (&lsum)[NMAP], float (&mrun)[NMAP], bf16x8 (&pf)[NMAP][2]) {
    constexpr int KPL = NMAP * 64 * 16, VPL = DV * 16, VS_OFF = NMAP * 64 * DQK * 2, NKS = DQK / 32;
    float al[NMAP]; bool resc = false;
#pragma unroll
    for (int mp = 0; mp < NMAP; ++mp) {
        f32x4 s[4];
        {
            bf16x8 kf[2][NKS];
#pragma unroll
            for (int ks = 0; ks < NKS; ++ks) kf[0][ks] = *(const LAS bf16x8*)(cur + (ks * 4 + g) * KPL + (mp * 64 + qi) * 16);
#pragma unroll
            for (int jb = 0; jb < 4; ++jb) { s[jb] = (f32x4){0.f, 0.f, 0.f, 0.f};
                if (jb < 3) {
#pragma unroll
                    for (int ks = 0; ks < NKS; ++ks) kf[(jb + 1) & 1][ks] = *(const LAS bf16x8*)(cur + (ks * 4 + g) * KPL + (mp * 64 + 16 * (jb + 1) + qi) * 16); }
                __builtin_amdgcn_sched_barrier(0);
#pragma unroll
                for (int ks = 0; ks < NKS; ++ks) s[jb] = __builtin_amdgcn_mfma_f32_16x16x32_bf16(kf[jb & 1][ks], qf[mp][ks], s[jb], 0, 0, 0);
                __builtin_amdgcn_sched_barrier(0); }
        }
        float mx = fmaxf(fmaxf(fmaxf(s[0][0], s[0][1]), fmaxf(s[0][2], s[0][3])), fmaxf(fmaxf(s[1][0], s[1][1]), fmaxf(s[1][2], s[1][3])));
        mx = fmaxf(mx, fmaxf(fmaxf(fmaxf(s[2][0], s[2][1]), fmaxf(s[2][2], s[2][3])), fmaxf(fmaxf(s[3][0], s[3][1]), fmaxf(s[3][2], s[3][3]))));
        mx = qmax4(mx);
        const bool upd = (mx - mrun[mp]) > 8.f; const float mnew = upd ? mx : mrun[mp]; al[mp] = upd ? __builtin_amdgcn_exp2f(mrun[mp] - mnew) : 1.f; resc = resc || upd; mrun[mp] = mnew;
        float ps = 0.f;
#pragma unroll
        for (int jb = 0; jb < 4; ++jb)
#pragma unroll
            for (int r = 0; r < 4; ++r) { s[jb][r] = __builtin_amdgcn_exp2f(s[jb][r] - mnew); ps += s[jb][r]; }
        lsum[mp] = lsum[mp] * al[mp] + ps;
#pragma unroll
        for (int tg = 0; tg < 2; ++tg) { v4u pw; pw.x = pkbf(s[2 * tg][0], s[2 * tg][1]); pw.y = pkbf(s[2 * tg][2], s[2 * tg][3]); pw.z = pkbf(s[2 * tg + 1][0], s[2 * tg + 1][1]); pw.w = pkbf(s[2 * tg + 1][2], s[2 * tg + 1][3]);
            pf[mp][tg] = __builtin_bit_cast(bf16x8, pw); }
    }
    if (__any(resc)) {
#pragma unroll
        for (int mp = 0; mp < NMAP; ++mp)
#pragma unroll
            for (int db = 0; db < DV / 16; ++db) O[mp][db] = O[mp][db] * al[mp];
    }
}
template <int NMAP, int DQK, int DV, int VBN_ = 0>
__device__ __forceinline__ void attn_pv(LAS unsigned char* cur, int qi, int g, const bf16x8 (&pf)[NMAP][2], f32x4 (&O)[NMAP][DV / 16]) {
    constexpr int VPL = DV * 16, VS_OFF = NMAP * 64 * DQK * 2;
    {
        constexpr int NDB = DV / 16, VBN = VBN_ ? VBN_ : ((DV > 128) ? 4 : 8), NBT = 2 * NDB / VBN;
        bf16x8 vf[2][VBN];
#pragma unroll
        for (int i = 0; i < VBN; ++i) vf[0][i] = *(const LAS bf16x8*)(cur + VS_OFF + g * VPL + (i * 16 + qi) * 16);
#pragma unroll
        for (int bt = 0; bt < NBT; ++bt) {
            if (bt + 1 < NBT) {
#pragma unroll
                for (int i = 0; i < VBN; ++i) { const int f = (bt + 1) * VBN + i, tg = f / NDB, db = f % NDB; vf[(bt + 1) & 1][i] = *(const LAS bf16x8*)(cur + VS_OFF + (tg * 4 + g) * VPL + (db * 16 + qi) * 16); } }
            __builtin_amdgcn_sched_barrier(0);
#pragma unroll
            for (int i = 0; i < VBN; ++i) { const int f = bt * VBN + i, tg = f / NDB, db = f % NDB;
#pragma unroll
                for (int mp = 0; mp < NMAP; ++mp) O[mp][db] = __builtin_amdgcn_mfma_f32_16x16x32_bf16(vf[bt & 1][i], pf[mp][tg], O[mp][db], 0, 0, 0); }
            __builtin_amdgcn_sched_barrier(0);
        }
    }
}
template <int NMAP, int DQK, int DV>
__device__ __forceinline__ void attn_tile(LAS unsigned char* cur, int qi, int g, const bf16x8 (&qf)[NMAP][DQK / 32], f32x4 (&O)[NMAP][DV / 16], float (&lsum)[NMAP], float (&mrun)[NMAP]) {
    bf16x8 pf[NMAP][2]; attn_qks<NMAP, DQK, DV>(cur, qi, g, qf, O, lsum, mrun, pf); attn_pv<NMAP, DQK, DV>(cur, qi, g, pf, O);
}
template <int NMAP, int DQK, int DV, bool DBUF>
__device__ __forceinline__ void attn_core(LAS unsigned char* lds, const bf16* Q, int qpitch, const bf16* K, int kpitch, const bf16* VT, int vpitch,
                                          int NT, int my_nt, f32x4 (&O)[NMAP][DV / 16], float (&lsum)[NMAP]) {
    constexpr int CPR = DQK / 8, KCH = NMAP * 64 * CPR / 512, VCH = DV * 8 / 512, KPL = NMAP * 64 * 16, VPL = DV * 16, VS_OFF = NMAP * 64 * DQK * 2, NKS = DQK / 32, NRG = NMAP * 8;
    constexpr int BUFB = VS_OFF + DV * 128;
    const int tid = tidx(), lane = tid & 63, qi = lane & 15, g = lane >> 4;
    bf16x8 qf[NMAP][NKS];
#pragma unroll
    for (int mp = 0; mp < NMAP; ++mp)
#pragma unroll
        for (int ks = 0; ks < NKS; ++ks) qf[mp][ks] = *(const bf16x8*)(Q + (size_t)qi * qpitch + mp * DQK + ks * 32 + g * 8);
    float mrun[NMAP];
#pragma unroll
    for (int mp = 0; mp < NMAP; ++mp) { mrun[mp] = -INFINITY; lsum[mp] = 0.f;
#pragma unroll
        for (int db = 0; db < DV / 16; ++db) O[mp][db] = (f32x4){0.f, 0.f, 0.f, 0.f}; }
    v4u kregA[KCH], vregA[VCH], kregB[DBUF ? KCH : 1], vregB[DBUF ? VCH : 1];
#define ATT_LOAD(t, KR, VR) do { _Pragma("unroll") for (int i = 0; i < KCH; ++i) { const int w64 = (tid >> 6) + i * 8, prow = (w64 % NRG) * 8 + (lane & 7), ch = (w64 / NRG) * 8 + (lane >> 3), p6 = prow & 63; \
            const int kv = (p6 & 32) + 8 * ((p6 >> 2) & 3) + 4 * ((p6 >> 4) & 1) + (p6 & 3); \
            KR[i] = *(const v4u*)(K + (size_t)((t) * 64 + kv) * kpitch + (prow >> 6) * DQK + ch * 8); } \
        _Pragma("unroll") for (int i = 0; i < VCH; ++i) { const int w64 = (tid >> 6) + i * 8, d = w64 * 8 + (lane & 7), ch = lane >> 3; \
            VR[i] = *(const v4u*)(VT + (size_t)d * vpitch + (t) * 64 + ch * 8); } } while (0)
#define ATT_STORE(B, KR, VR) do { _Pragma("unroll") for (int i = 0; i < KCH; ++i) { const int w64 = (tid >> 6) + i * 8, prow = (w64 % NRG) * 8 + (lane & 7), ch = (w64 / NRG) * 8 + (lane >> 3); *(LAS v4u*)((B) + ch * KPL + prow * 16) = KR[i]; } \
        _Pragma("unroll") for (int i = 0; i < VCH; ++i) { const int w64 = (tid >> 6) + i * 8, d = w64 * 8 + (lane & 7), ch = lane >> 3; *(LAS v4u*)((B) + VS_OFF + ch * VPL + d * 16) = VR[i]; } } while (0)
    if (DBUF) {
        ATT_LOAD(0, kregA, vregA);
        __syncthreads(); ATT_STORE(lds, kregA, vregA);
        ATT_LOAD(1, kregA, vregA); if (NT > 2) ATT_LOAD(2, kregB, vregB);
        __syncthreads();
        for (int t = 0; t < NT; t += 2) {
            ATT_STORE(lds + BUFB, kregA, vregA); if (t + 3 < NT) ATT_LOAD(t + 3, kregA, vregA);
            if (t < my_nt) attn_tile<NMAP, DQK, DV>(lds, qi, g, qf, O, lsum, mrun);
            __syncthreads();
            if (t + 2 < NT) { ATT_STORE(lds, kregB, vregB); if (t + 4 < NT) ATT_LOAD(t + 4, kregB, vregB); }
            if (t + 1 < my_nt) attn_tile<NMAP, DQK, DV>(lds + BUFB, qi, g, qf, O, lsum, mrun);
            __syncthreads();
        }
    } else {
        ATT_LOAD(0, kregA, vregA);
        for (int t = 0; t < NT; ++t) {
            __syncthreads(); ATT_STORE(lds, kregA, vregA); __syncthreads(); if (t + 1 < NT) ATT_LOAD(t + 1, kregA, vregA);
            if (t < my_nt) attn_tile<NMAP, DQK, DV>(lds, qi, g, qf, O, lsum, mrun);
        }
    }
#undef ATT_LOAD
#undef ATT_STORE
#pragma unroll
    for (int mp = 0; mp < NMAP; ++mp) { lsum[mp] += __shfl_xor(lsum[mp], 16); lsum[mp] += __shfl_xor(lsum[mp], 32); }
}

__device__ __forceinline__ void diff_core_skew(LAS unsigned char* lds, const bf16* Q, int qpitch, const bf16* K, int kpitch, const bf16* VT, int vpitch,
                                               int NT, int my_nt, bool lag, f32x4 (&O)[2][8], float (&lsum)[2]) {
    constexpr int NMAP = 2, DQK = 64, DV = 128, CPR = 8, KCH = 2, VCH = 2, KPL = NMAP * 64 * 16, VPL = DV * 16, VS_OFF = NMAP * 64 * DQK * 2, NRG = NMAP * 8, BUFB = VS_OFF + DV * 128;
    const int tid = tidx(), lane = tid & 63, qi = lane & 15, g = lane >> 4;
    bf16x8 qf[2][2];
#pragma unroll
    for (int mp = 0; mp < 2; ++mp)
#pragma unroll
        for (int ks = 0; ks < 2; ++ks) qf[mp][ks] = *(const bf16x8*)(Q + (size_t)qi * qpitch + mp * DQK + ks * 32 + g * 8);
    float mrun[2] = {-INFINITY, -INFINITY}; lsum[0] = 0.f; lsum[1] = 0.f;
#pragma unroll
    for (int mp = 0; mp < 2; ++mp)
#pragma unroll
        for (int db = 0; db < 8; ++db) O[mp][db] = (f32x4){0.f, 0.f, 0.f, 0.f};
    v4u kregA[KCH], vregA[VCH], kregB[KCH], vregB[VCH];
#define SK_LOAD(t, KR, VR) do { _Pragma("unroll") for (int i = 0; i < KCH; ++i) { const int w64 = (tid >> 6) + i * 8, prow = (w64 % NRG) * 8 + (lane & 7), ch = (w64 / NRG) * 8 + (lane >> 3), p6 = prow & 63; \
            const int kv = (p6 & 32) + 8 * ((p6 >> 2) & 3) + 4 * ((p6 >> 4) & 1) + (p6 & 3); \
            KR[i] = *(const v4u*)(K + (size_t)((t) * 64 + kv) * kpitch + (prow >> 6) * DQK + ch * 8); } \
        _Pragma("unroll") for (int i = 0; i < VCH; ++i) { const int w64 = (tid >> 6) + i * 8, d = w64 * 8 + (lane & 7), ch = lane >> 3; \
            VR[i] = *(const v4u*)(VT + (size_t)d * vpitch + (t) * 64 + ch * 8); } } while (0)
#define SK_STORE(B, KR, VR) do { _Pragma("unroll") for (int i = 0; i < KCH; ++i) { const int w64 = (tid >> 6) + i * 8, prow = (w64 % NRG) * 8 + (lane & 7), ch = (w64 / NRG) * 8 + (lane >> 3); *(LAS v4u*)((B) + ch * KPL + prow * 16) = KR[i]; } \
        _Pragma("unroll") for (int i = 0; i < VCH; ++i) { const int w64 = (tid >> 6) + i * 8, d = w64 * 8 + (lane & 7), ch = lane >> 3; *(LAS v4u*)((B) + VS_OFF + ch * VPL + d * 16) = VR[i]; } } while (0)
    bf16x8 pfp[2][2];
#pragma unroll
    for (int mp = 0; mp < 2; ++mp) { pfp[mp][0] = (bf16x8){0, 0, 0, 0, 0, 0, 0, 0}; pfp[mp][1] = pfp[mp][0]; }
#define SK_STEP(t, ic, ip, in_) do { \
        if (!lag) { if ((t) < my_nt) { bf16x8 pf_[2][2]; attn_qks<2, 64, 128>(lds + (ic) * BUFB, qi, g, qf, O, lsum, mrun, pf_); attn_pv<2, 64, 128, 4>(lds + (ic) * BUFB, qi, g, pf_, O); } } \
        else { if ((t) >= 1 && (t) - 1 < my_nt) attn_pv<2, 64, 128, 4>(lds + (ip) * BUFB, qi, g, pfp, O); \
               if ((t) < my_nt) attn_qks<2, 64, 128>(lds + (ic) * BUFB, qi, g, qf, O, lsum, mrun, pfp); } } while (0)
    SK_LOAD(0, kregA, vregA); SK_LOAD(1, kregB, vregB);
    __syncthreads(); SK_STORE(lds, kregA, vregA);
    if (NT > 2) SK_LOAD(2, kregA, vregA);
    __syncthreads();
    int ic = 0, ip = 2, in_ = 1;
    for (int t = 0; t < NT; t += 2) {
        SK_STORE(lds + in_ * BUFB, kregB, vregB); if (t + 3 < NT) SK_LOAD(t + 3, kregB, vregB);
        SK_STEP(t, ic, ip, in_);
        __syncthreads();
        ip = ic; ic = in_; in_ = in_ == 2 ? 0 : in_ + 1;
        if (t + 2 < NT) { SK_STORE(lds + in_ * BUFB, kregA, vregA); if (t + 4 < NT) SK_LOAD(t + 4, kregA, vregA); }
        SK_STEP(t + 1, ic, ip, in_);
        __syncthreads();
        ip = ic; ic = in_; in_ = in_ == 2 ? 0 : in_ + 1;
    }
    if (lag && NT - 1 < my_nt) attn_pv<2, 64, 128, 4>(lds + ip * BUFB, qi, g, pfp, O);
#undef SK_LOAD
#undef SK_STORE
#undef SK_STEP
    lsum[0] += __shfl_xor(lsum[0], 16); lsum[0] += __shfl_xor(lsum[0], 32); lsum[1] += __shfl_xor(lsum[1], 16); lsum[1] += __shfl_xor(lsum[1], 32);
}
__device__ __forceinline__ void diffattn_phase(CArgs& A, LAS unsigned char* lds, int l) {
    l = lnd(l);
    const int tid = tidx(), lane = tid & 63, wave = tid >> 6, qi = lane & 15, g = lane >> 4;
    const bf16* P = (const bf16*)(A.ws + WS_HP); const bf16* VT = (const bf16*)((unsigned char*)A.out + OUT_VT); bf16* CAT = (bf16*)(A.ws + WS_CAT);
    const float lambda_init = 0.8f - 0.6f * expf(-0.3f * (float)l);
    float lam; { const float* dl = A.in[12] + l * 256; float a = 0.f, b2 = 0.f; for (int i = 0; i < 64; ++i) { a += dl[i] * dl[64 + i]; b2 += dl[128 + i] * dl[192 + i]; } lam = expf(a) - expf(b2) + lambda_init; }
    const float* gn = A.in[13] + l * 128;
    const int nblk = gdim(), bid = bidx(); const bool xcd_ok = (nblk == 256);
    for (int it = 0, pi0 = bid; pi0 < 1024; pi0 += nblk, ++it) {
        int pi = pi0; if (xcd_ok) { const int xcd = bid & 7, j = bid >> 3; pi = ((xcd * 8 + it * 2 + (j >> 4)) << 4) | (j & 15); }
        const int bh = pi >> 4, s = pi & 15, b = bh >> 2, h = bh & 3;
        for (int half = 0; half < 2; ++half) {
            const int qblk = half ? 31 - s : s, NT = 2 * qblk + 2, my_nt = 2 * qblk + (wave >> 2) + 1;
            const size_t row0 = (size_t)b * 4096 + qblk * 128 + wave * 16;
            f32x4 O[2][8]; float ls[2];
            diff_core_skew(lds, P + row0 * NPJ + h * 128, NPJ, P + (size_t)b * 4096 * NPJ + 512 + h * 128, NPJ, VT + (size_t)((b * 4 + h) * 128) * 4096, 4096, NT, my_nt, wave >= 4, O, ls);
            const float i1 = 1.f / ls[0], i2 = lam / ls[1]; float ss = 0.f;
#pragma unroll
            for (int db = 0; db < 8; ++db) { O[0][db] = O[0][db] * i1 - O[1][db] * i2; ss += (O[0][db][0] * O[0][db][0] + O[0][db][1] * O[0][db][1]) + (O[0][db][2] * O[0][db][2] + O[0][db][3] * O[0][db][3]); }
            ss += __shfl_xor(ss, 16); ss += __shfl_xor(ss, 32);
            const float rs = (1.f - lambda_init) / sqrtf(ss * (1.f / 128.f) + EPS);
            LAS unsigned char* stg = lds + 98304 + wave * 4352;
#pragma unroll
            for (int db = 0; db < 8; ++db) { const f32x4 gg = *(const f32x4*)(gn + db * 16 + 4 * g); const f32x4 v = O[0][db] * rs * gg; v2u w; w.x = pkbf(v[0], v[1]); w.y = pkbf(v[2], v[3]); *(LAS v2u*)(stg + qi * 272 + (16 * db + 4 * g) * 2) = w; }
            asm volatile("s_waitcnt lgkmcnt(0)" ::: "memory");
#pragma unroll
            for (int i = 0; i < 4; ++i) { const int idx = i * 64 + lane, row = idx >> 4, ch = idx & 15; const v4u v = *(const LAS v4u*)(stg + row * 272 + ch * 16);
                *(v4u*)(CAT + (row0 + row) * DM + h * 128 + ch * 8) = v; }
            asm volatile("s_waitcnt lgkmcnt(0)" ::: "memory");
        }
    }
    __syncthreads();
}
__device__ __forceinline__ void xattn_phase(CArgs& A, LAS unsigned char* lds) {
    const int tid = tidx(), lane = tid & 63, wave = tid >> 6, qi = lane & 15, g = lane >> 4;
    const bf16* QX = (const bf16*)(A.ws + WS_HP); bf16* OX = (bf16*)(A.ws + WS_HP + 128 * MiB); const bf16* KX = (const bf16*)(A.ws + WS_KX); const bf16* VTX = (const bf16*)(A.ws + WS_VTX);
    for (int u = bidx(); u < 2048; u += gdim()) {
        const int b = u >> 7, h = (u >> 5) & 3, qblk = u & 31; const size_t row0 = (size_t)b * 4096 + qblk * 128 + wave * 16;
        f32x4 O[1][16]; float ls[1];
        attn_core<1, 256, 256, false>(lds, QX + row0 * DM + h * 256, DM, KX + (size_t)b * 256 * DM + h * 256, DM, VTX + (size_t)((b * 4 + h) * 256) * 256, 256, 4, 4, O, ls);
        const float il = 1.f / ls[0]; LAS unsigned char* stg = lds + 65536 + wave * 8448;
#pragma unroll
        for (int db = 0; db < 16; ++db) { const f32x4 v = O[0][db] * il; v2u w; w.x = pkbf(v[0], v[1]); w.y = pkbf(v[2], v[3]); *(LAS v2u*)(stg + qi * 528 + (16 * db + 4 * g) * 2) = w; }
        asm volatile("s_waitcnt lgkmcnt(0)" ::: "memory");
#pragma unroll
        for (int i = 0; i < 8; ++i) { const int idx = i * 64 + lane, row = idx >> 5, ch = idx & 31; const v4u v = *(const LAS v4u*)(stg + row * 528 + ch * 16);
            *(v4u*)(OX + (row0 + row) * DM + h * 256 + ch * 8) = v; }
        asm volatile("s_waitcnt lgkmcnt(0)" ::: "memory");
    }
    __syncthreads();
}

__device__ __forceinline__ void conv8(CArgs& A, int l, const bf16* P, int b, int pos, int col, int cch, float (&o)[8]) {
    const float* cw = A.in[8] + l * 2048; const float* cb = A.in[9] + l * 512;
#pragma unroll
    for (int e = 0; e < 8; ++e) o[e] = cb[cch + e];
#pragma unroll
    for (int j = 0; j < 4; ++j) { const int pj = pos - 3 + j; if (pj >= 0) { const v4u x = *(const v4u*)(P + ((size_t)b * 4096 + pj) * NPJ + col); const float* w = cw + j * 512 + cch;
            o[0] += w[0] * bflo(x.x); o[1] += w[1] * bfhi(x.x); o[2] += w[2] * bflo(x.y); o[3] += w[3] * bfhi(x.y); o[4] += w[4] * bflo(x.z); o[5] += w[5] * bfhi(x.z); o[6] += w[6] * bflo(x.w); o[7] += w[7] * bfhi(x.w); } }
#pragma unroll
    for (int e = 0; e < 8; ++e) o[e] = siluf_(o[e]);
}
__device__ __forceinline__ float logsigmoidf_(float x) { return fminf(x, 0.f) - log1pf(__expf(-fabsf(x))); }
constexpr int ML_Q = 0, ML_KT = 4160, ML_V = 8256, ML_P = 12352, ML_CT = 16512, ML_MISC = 20608;
__device__ __forceinline__ void mlstm_local(CArgs& A, LAS unsigned char* lds, int l) {
    l = lnd(l);
    const int tid = tidx(), lane = tid & 63, wave = tid >> 6, half = wave >> 2, hw = wave & 3, ht = tid & 255, qi = lane & 15, g = lane >> 4;
    constexpr int PT = 72, HB = 20480;
    LAS unsigned char* hb = lds + half * HB; LAS float* wt = (LAS float*)(hb + 18432);
    const bf16* P = (const bf16*)(A.ws + WS_HP); const float* GT = (const float*)(A.ws + WS_GATES); const float* gb = A.in[10] + l * 8;
    float* Cb = (float*)((unsigned char*)A.out + OUT_C); float* Nb = (float*)(A.ws + WS_NST); float* AB = (float*)(A.ws + WS_AB);
    const int nblk_ = gdim(), bid_ = bidx(); const bool deal = nblk_ == 256;
    const int np_ = deal ? (bid_ < 64 ? 5 : 9) : (2048 - bid_ + nblk_ - 1) / nblk_, p0_ = deal ? (bid_ < 64 ? bid_ * 5 : 320 + (bid_ - 64) * 9) : bid_, ps_ = deal ? 1 : nblk_;
    for (int ip_ = 0; ip_ < np_; ++ip_) { const int u0 = 2 * (p0_ + ip_ * ps_);
        const int u = u0 + half, bh = u >> 6, c = u & 63, b = bh >> 2, h = bh & 3; const int s = ht >> 2, d16 = (ht & 3) * 16, pos = c * 64 + s;
        const size_t prow = ((size_t)b * 4096 + pos) * NPJ;
        const v4u x0 = *(const v4u*)(P + prow + 2048 + h * 64 + d16), x1 = *(const v4u*)(P + prow + 2048 + h * 64 + d16 + 8);
        { float k0[8], k1[8]; conv8(A, l, P, b, pos, 1792 + h * 64 + d16, 256 + h * 64 + d16, k0); conv8(A, l, P, b, pos, 1792 + h * 64 + d16 + 8, 256 + h * 64 + d16 + 8, k1);
          LAS bf16* kt = (LAS bf16*)(hb + 9216) + d16 * PT + s;
#pragma unroll
          for (int e = 0; e < 8; e += 2) { const unsigned w0 = pkbf(k0[e] * 0.125f, k0[e + 1] * 0.125f), w1 = pkbf(k1[e] * 0.125f, k1[e + 1] * 0.125f);
              kt[e * PT] = (bf16)(w0 & 0xffff); kt[(e + 1) * PT] = (bf16)(w0 >> 16); kt[(8 + e) * PT] = (bf16)(w1 & 0xffff); kt[(9 + e) * PT] = (bf16)(w1 >> 16); } }
        if (hw == 0) { const size_t row = (size_t)b * 4096 + c * 64 + lane; const float ig = GT[row * 8 + h] + gb[h]; float bc = logsigmoidf_(GT[row * 8 + 4 + h] + gb[4 + h]);
#pragma unroll
            for (int o = 1; o < 64; o <<= 1) { const float nb = __shfl_up(bc, o); if (lane >= o) bc += nb; }
            const float bl = __shfl(bc, 63), val = bl - bc + ig, a = wave_max(val); wt[lane] = __expf(val - a);
            if (lane == 0) { AB[2 * u] = a; AB[2 * u + 1] = bl; } }
        __syncthreads();
        { const float w = wt[s]; LAS bf16* vt = (LAS bf16*)hb + d16 * PT + s;
          const unsigned xs[8] = {x0.x, x0.y, x0.z, x0.w, x1.x, x1.y, x1.z, x1.w};
#pragma unroll
          for (int e = 0; e < 8; ++e) { const unsigned p = pkbf(bflo(xs[e]) * w, bfhi(xs[e]) * w); vt[(2 * e) * PT] = (bf16)(p & 0xffff); vt[(2 * e + 1) * PT] = (bf16)(p >> 16); } }
        __syncthreads();
        {
            bf16x8 af[2];
#pragma unroll
            for (int ks = 0; ks < 2; ++ks) af[ks] = *(const LAS bf16x8*)(hb + ((hw * 16 + qi) * PT + ks * 32 + g * 8) * 2);
            float* cp = Cb + (size_t)u * 4096 + (hw * 16 + 4 * g) * 64 + qi;
#pragma unroll
            for (int kb = 0; kb < 4; ++kb) { f32x4 acc = (f32x4){0.f, 0.f, 0.f, 0.f};
#pragma unroll
                for (int ks = 0; ks < 2; ++ks) { const bf16x8 bfr = *(const LAS bf16x8*)(hb + 9216 + ((kb * 16 + qi) * PT + ks * 32 + g * 8) * 2); acc = __builtin_amdgcn_mfma_f32_16x16x32_bf16(af[ks], bfr, acc, 0, 0, 0); }
                cp[0 * 64 + kb * 16] = acc[0]; cp[1 * 64 + kb * 16] = acc[1]; cp[2 * 64 + kb * 16] = acc[2]; cp[3 * 64 + kb * 16] = acc[3]; }
            if (ht < 64) { float n = 0.f; const LAS bf16* kr = (const LAS bf16*)(hb + 9216) + ht * PT;
#pragma unroll 8
                for (int ss = 0; ss < 64; ++ss) n += wt[ss] * bf2f(kr[ss]);
                Nb[(size_t)u * 64 + ht] = n; }
        }
        __syncthreads();
    }
}
__device__ __forceinline__ void mlstm_scan(CArgs& A) {
    const int gt = bidx() * 512 + tidx(), NGT = gdim() * 512;
    float* Cb = (float*)((unsigned char*)A.out + OUT_C); float* Nb = (float*)(A.ws + WS_NST); const float* AB = (const float*)(A.ws + WS_AB); float* MS = (float*)(A.ws + WS_MS);
    for (int idx = gt; idx < 64 * 4160; idx += NGT) { const int bh = idx / 4160, e = idx % 4160; float st = 0.f, m = 0.f;
        float* base = e < 4096 ? Cb + (size_t)bh * 64 * 4096 + e : Nb + (size_t)bh * 64 * 64 + (e - 4096); const size_t stride = e < 4096 ? 4096 : 64;
        for (int c0 = 0; c0 < 64; c0 += 8) { float d[8], a[8], bl[8];
#pragma unroll
            for (int j = 0; j < 8; ++j) { d[j] = base[(size_t)(c0 + j) * stride]; a[j] = AB[2 * (bh * 64 + c0 + j)]; bl[j] = AB[2 * (bh * 64 + c0 + j) + 1]; }
#pragma unroll
            for (int j = 0; j < 8; ++j) { base[(size_t)(c0 + j) * stride] = st; if (e == 0) MS[bh * 64 + c0 + j] = m;
                const float mn = fmaxf(bl[j] + m, a[j]); st = __expf(bl[j] + m - mn) * st + __expf(a[j] - mn) * d[j]; m = mn; } } }
}
__device__ __forceinline__ void mlstm_out(CArgs& A, LAS unsigned char* lds, int l) {
    l = lnd(l);
    const int tid = tidx(), lane = tid & 63, wave = tid >> 6, half = wave >> 2, hw = wave & 3, ht = tid & 255, qi = lane & 15, g = lane >> 4;
    constexpr int PT = 72, HB = 40960;
    LAS unsigned char* hb = lds + half * HB; LAS float* tb = (LAS float*)(hb + 27648);
    const bf16* P = (const bf16*)(A.ws + WS_HP); const float* GT = (const float*)(A.ws + WS_GATES); const float* gb = A.in[10] + l * 8;
    const float* Cb = (const float*)((unsigned char*)A.out + OUT_C); const float* Nb = (const float*)(A.ws + WS_NST); const float* MS = (const float*)(A.ws + WS_MS); bf16* CAT = (bf16*)(A.ws + WS_CAT);
    const float* ng = A.in[11] + l * 256;
    for (int u0 = bidx() * 2; u0 < 4096; u0 += gdim() * 2) {
        const int u = u0 + half, bh = u >> 6, c = u & 63, b = bh >> 2, h = bh & 3;
        { const int s = ht >> 2, d16 = (ht & 3) * 16, pos = c * 64 + s; const size_t prow = ((size_t)b * 4096 + pos) * NPJ;
          float k0[8], k1[8]; conv8(A, l, P, b, pos, 1792 + h * 64 + d16, 256 + h * 64 + d16, k0); conv8(A, l, P, b, pos, 1792 + h * 64 + d16 + 8, 256 + h * 64 + d16 + 8, k1);
          v4u w; w.x = pkbf(k0[0] * 0.125f, k0[1] * 0.125f); w.y = pkbf(k0[2] * 0.125f, k0[3] * 0.125f); w.z = pkbf(k0[4] * 0.125f, k0[5] * 0.125f); w.w = pkbf(k0[6] * 0.125f, k0[7] * 0.125f);
          *(LAS v4u*)(hb + (s * PT + d16) * 2) = w;
          w.x = pkbf(k1[0] * 0.125f, k1[1] * 0.125f); w.y = pkbf(k1[2] * 0.125f, k1[3] * 0.125f); w.z = pkbf(k1[4] * 0.125f, k1[5] * 0.125f); w.w = pkbf(k1[6] * 0.125f, k1[7] * 0.125f);
          *(LAS v4u*)(hb + (s * PT + d16 + 8) * 2) = w;
          const v4u x0 = *(const v4u*)(P + prow + 2048 + h * 64 + d16), x1 = *(const v4u*)(P + prow + 2048 + h * 64 + d16 + 8);
          LAS bf16* vt = (LAS bf16*)(hb + 9216) + d16 * PT + s;
          vt[0 * PT] = (bf16)(x0.x & 0xffff); vt[1 * PT] = (bf16)(x0.x >> 16); vt[2 * PT] = (bf16)(x0.y & 0xffff); vt[3 * PT] = (bf16)(x0.y >> 16);
          vt[4 * PT] = (bf16)(x0.z & 0xffff); vt[5 * PT] = (bf16)(x0.z >> 16); vt[6 * PT] = (bf16)(x0.w & 0xffff); vt[7 * PT] = (bf16)(x0.w >> 16);
          vt[8 * PT] = (bf16)(x1.x & 0xffff); vt[9 * PT] = (bf16)(x1.x >> 16); vt[10 * PT] = (bf16)(x1.y & 0xffff); vt[11 * PT] = (bf16)(x1.y >> 16);
          vt[12 * PT] = (bf16)(x1.z & 0xffff); vt[13 * PT] = (bf16)(x1.z >> 16); vt[14 * PT] = (bf16)(x1.w & 0xffff); vt[15 * PT] = (bf16)(x1.w >> 16);
          const float* cp = Cb + (size_t)u * 4096 + s * 64 + d16;
          const f32x4 c0 = *(const f32x4*)cp, c1 = *(const f32x4*)(cp + 4), c2 = *(const f32x4*)(cp + 8), c3 = *(const f32x4*)(cp + 12);
          w.x = pkbf(c0[0], c0[1]); w.y = pkbf(c0[2], c0[3]); w.z = pkbf(c1[0], c1[1]); w.w = pkbf(c1[2], c1[3]); *(LAS v4u*)(hb + 18432 + (s * PT + d16) * 2) = w;
          w.x = pkbf(c2[0], c2[1]); w.y = pkbf(c2[2], c2[3]); w.z = pkbf(c3[0], c3[1]); w.w = pkbf(c3[2], c3[3]); *(LAS v4u*)(hb + 18432 + (s * PT + d16 + 8) * 2) = w;
          if (ht < 64) tb[256 + ht] = Nb[(size_t)u * 64 + ht]; }
        if (hw == 0) { const size_t row = (size_t)b * 4096 + c * 64 + lane; const float ig = GT[row * 8 + h] + gb[h]; float bc = logsigmoidf_(GT[row * 8 + 4 + h] + gb[4 + h]);
#pragma unroll
            for (int o = 1; o < 64; o <<= 1) { const float nb = __shfl_up(bc, o); if (lane >= o) bc += nb; }
            const float gs = ig - bc; float pm = gs;
#pragma unroll
            for (int o = 1; o < 64; o <<= 1) { const float nb = __shfl_up(pm, o); if (lane >= o) pm = fmaxf(pm, nb); }
            const float mc = MS[u], Mt = fmaxf(mc, pm);
            tb[lane] = gs; tb[64 + lane] = Mt; tb[128 + lane] = __expf(mc - Mt); tb[192 + lane] = __expf(-(bc + Mt)); }
        const int tl = hw * 16 + qi; bf16x8 qf[2]; float nq = 0.f;
        float qv[2][8];
#pragma unroll
        for (int ks = 0; ks < 2; ++ks) { conv8(A, l, P, b, c * 64 + tl, 1536 + h * 64 + ks * 32 + g * 8, h * 64 + ks * 32 + g * 8, qv[ks]);
            v4u w; w.x = pkbf(qv[ks][0], qv[ks][1]); w.y = pkbf(qv[ks][2], qv[ks][3]); w.z = pkbf(qv[ks][4], qv[ks][5]); w.w = pkbf(qv[ks][6], qv[ks][7]); qf[ks] = __builtin_bit_cast(bf16x8, w); }
        __syncthreads();
#pragma unroll
        for (int ks = 0; ks < 2; ++ks) { const f32x4 n0 = *(const LAS f32x4*)(tb + 256 + ks * 32 + g * 8), n1 = *(const LAS f32x4*)(tb + 256 + ks * 32 + g * 8 + 4);
            nq += (qv[ks][0] * n0[0] + qv[ks][1] * n0[1]) + (qv[ks][2] * n0[2] + qv[ks][3] * n0[3]) + (qv[ks][4] * n1[0] + qv[ks][5] * n1[1]) + (qv[ks][6] * n1[2] + qv[ks][7] * n1[3]); }
        nq += __shfl_xor(nq, 16); nq += __shfl_xor(nq, 32);
        const float Mt = tb[64 + tl], inter = tb[128 + tl], emt = tb[192 + tl];
        bf16x8 pf[2]; float dsum = 0.f;
#pragma unroll
        for (int tg = 0; tg < 2; ++tg) { f32x4 sv[2];
#pragma unroll
            for (int j = 0; j < 2; ++j) { sv[j] = (f32x4){0.f, 0.f, 0.f, 0.f}; const int rowp = 32 * tg + 8 * (qi >> 2) + 4 * j + (qi & 3);
#pragma unroll
                for (int ks = 0; ks < 2; ++ks) { const bf16x8 a = *(const LAS bf16x8*)(hb + (rowp * PT + ks * 32 + g * 8) * 2); sv[j] = __builtin_amdgcn_mfma_f32_16x16x32_bf16(a, qf[ks], sv[j], 0, 0, 0); }
                const int s0 = 32 * tg + 8 * g + 4 * j; const f32x4 gsv = *(const LAS f32x4*)(tb + s0);
#pragma unroll
                for (int r = 0; r < 4; ++r) { const float pv = (s0 + r <= tl) ? sv[j][r] * __expf(gsv[r] - Mt) : 0.f; sv[j][r] = pv; dsum += pv; } }
            v4u pw; pw.x = pkbf(sv[0][0], sv[0][1]); pw.y = pkbf(sv[0][2], sv[0][3]); pw.z = pkbf(sv[1][0], sv[1][1]); pw.w = pkbf(sv[1][2], sv[1][3]); pf[tg] = __builtin_bit_cast(bf16x8, pw); }
        dsum += __shfl_xor(dsum, 16); dsum += __shfl_xor(dsum, 32);
        const float den = fmaxf(fabsf(dsum + inter * nq), emt), iden = 1.f / den;
        f32x4 o1[4], o2[4]; float ssq = 0.f;
#pragma unroll
        for (int db = 0; db < 4; ++db) { o1[db] = (f32x4){0.f, 0.f, 0.f, 0.f}; o2[db] = (f32x4){0.f, 0.f, 0.f, 0.f};
#pragma unroll
            for (int tg = 0; tg < 2; ++tg) { const bf16x8 a = *(const LAS bf16x8*)(hb + 9216 + ((db * 16 + qi) * PT + tg * 32 + g * 8) * 2); o1[db] = __builtin_amdgcn_mfma_f32_16x16x32_bf16(a, pf[tg], o1[db], 0, 0, 0); }
#pragma unroll
            for (int ks = 0; ks < 2; ++ks) { const bf16x8 a = *(const LAS bf16x8*)(hb + 18432 + ((db * 16 + qi) * PT + ks * 32 + g * 8) * 2); o2[db] = __builtin_amdgcn_mfma_f32_16x16x32_bf16(a, qf[ks], o2[db], 0, 0, 0); }
            o1[db] = (o1[db] + o2[db] * inter) * iden; ssq += (o1[db][0] * o1[db][0] + o1[db][1] * o1[db][1]) + (o1[db][2] * o1[db][2] + o1[db][3] * o1[db][3]); }
        ssq += __shfl_xor(ssq, 16); ssq += __shfl_xor(ssq, 32);
        const float rs = 1.f / sqrtf(ssq * (1.f / 64.f) + EPS); const size_t row = (size_t)b * 4096 + c * 64 + tl;
#pragma unroll
        for (int db = 0; db < 4; ++db) { const int vcol = h * 64 + db * 16 + 4 * g; const v2u mo = *(const v2u*)(P + row * NPJ + 2304 + vcol); const f32x4 gv = *(const f32x4*)(ng + vcol);
            v2u w; w.x = pkbf(o1[db][0] * rs * gv[0] * sigmoidf_(bflo(mo.x)), o1[db][1] * rs * gv[1] * sigmoidf_(bfhi(mo.x))); w.y = pkbf(o1[db][2] * rs * gv[2] * sigmoidf_(bflo(mo.y)), o1[db][3] * rs * gv[3] * sigmoidf_(bfhi(mo.y)));
            *(v2u*)(CAT + row * DM + 512 + vcol) = w; }
        __syncthreads();
    }
}
__device__ __forceinline__ void s5_scan(CArgs& A, int l) {
    l = lnd(l);
    const int gt = bidx() * 512 + tidx(), NGT = gdim() * 512;
    const float* E = (const float*)(A.ws + WS_EOUT); const float* LAML = (const float*)(A.ws + WS_LAML) + l * LAML_L; bf16* SUX = (bf16*)((unsigned char*)A.out + OUT_SUX);
    for (int idx = gt; idx < 16384; idx += NGT) { const int b = idx >> 10, g = (idx >> 6) & 15, p = idx & 63; const float lr = LAML[2 * (g * 64 + p)], li = LAML[2 * (g * 64 + p) + 1]; float xr = 0.f, xi = 0.f;
        for (int c0 = 0; c0 < 64; c0 += 8) { f32x2 e[8];
#pragma unroll
            for (int j = 0; j < 8; ++j) e[j] = *(const f32x2*)(E + ((size_t)g * 1024 + b * 64 + c0 + j) * 128 + 2 * p);
#pragma unroll
            for (int j = 0; j < 8; ++j) { *(unsigned*)(SUX + ((size_t)g * 1024 + b * 64 + c0 + j) * 1152 + 1024 + 2 * p) = pkbf(xr, xi);
                const float nr = lr * xr - li * xi + e[j].x, ni = lr * xi + li * xr + e[j].y; xr = nr; xi = ni; } } }
}

#define XB_TMO      128
#define XB_XCNT(j)  (256  + 64 * (j))
#define XB_XSUB(j)  (1280 + 64 * (j))
#define XB_XGEN(j)  (2304 + 64 * (j))
#define XB_TOP      3328
#define XB_TOPGEN   3392
#define XCD_BAR_WORDS 3456
#define XB_SPIN_CAP (1u << 18)

__device__ __forceinline__ unsigned xb_ld(unsigned* p)              { return __hip_atomic_load(p, __ATOMIC_RELAXED, __HIP_MEMORY_SCOPE_AGENT); }
__device__ __forceinline__ unsigned xb_add(unsigned* p, unsigned v) { return __hip_atomic_fetch_add(p, v, __ATOMIC_RELAXED, __HIP_MEMORY_SCOPE_AGENT); }
__device__ __forceinline__ unsigned xb_xcc_id() { return (unsigned)__builtin_amdgcn_s_getreg((3 << 11) | 20) & 0xFu; }
#define XB_SPIN(cond, bar) do { unsigned _sp = 0; while (cond) { __builtin_amdgcn_s_sleep(1); \
    if ((++_sp & 255u) == 0u) { if (xb_ld(&(bar)[XB_TMO])) break; if (_sp > XB_SPIN_CAP) { atomicAdd(&(bar)[XB_TMO], 1u); break; } } } } while (0)

struct XcdBarrier {
    unsigned* bar; unsigned x;
    volatile LAS unsigned* st;
};

__device__ __forceinline__ XcdBarrier xcd_barrier_post(unsigned* bar, volatile LAS unsigned* st) {
    XcdBarrier b; b.bar = bar; b.x = xb_xcc_id(); b.st = st;
    if (threadIdx.x == 0) (void)xb_add(&bar[XB_XCNT(b.x)], 1u);
    return b;
}
__device__ __forceinline__ void xcd_barrier_complete(unsigned* bar, unsigned x, unsigned& nloc, unsigned& nx) {
    const unsigned G = gridDim.x * gridDim.y * gridDim.z;
    unsigned sum, cnt, mine, sp = 0u;
    for (;;) {
        sum = 0u; cnt = 0u; mine = 0u;
#pragma unroll
        for (unsigned j = 0; j < 16; ++j) { const unsigned c = xb_ld(&bar[XB_XCNT(j)]); sum += c; cnt += (c > 0u) ? 1u : 0u; mine = (j == x) ? c : mine; }
        if (sum == G) break;
        __builtin_amdgcn_s_sleep(1);
        if ((++sp & 255u) == 0u) { if (xb_ld(&bar[XB_TMO])) break; if (sp > XB_SPIN_CAP) { atomicAdd(&bar[XB_TMO], 1u); break; } }
    }
    nloc = mine > 0u ? mine : 1u; nx = cnt > 0u ? cnt : 1u;
}

__device__ __forceinline__ void xcd_barrier(const XcdBarrier& b) {
    asm volatile("s_waitcnt vmcnt(0)" ::: "memory");
    __syncthreads();
    if (threadIdx.x == 0) {
        unsigned* bar = b.bar;
        __builtin_amdgcn_s_waitcnt(0);
        unsigned nloc = b.st[0], nx = b.st[1];
        if (nloc == 0u) { xcd_barrier_complete(bar, b.x, nloc, nx); b.st[0] = nloc; b.st[1] = nx; }
        const unsigned old = xb_add(&bar[XB_XSUB(b.x)], 1u);
        const unsigned gen = old / nloc;
        if (old + 1u == (gen + 1u) * nloc) {
            __builtin_amdgcn_fence(__ATOMIC_RELEASE, "agent");
            asm volatile("s_waitcnt vmcnt(0)" ::: "memory");
            const unsigned og = xb_add(&bar[XB_TOP], 1u);
            const unsigned tg = og / nx;
            if (og + 1u == (tg + 1u) * nx) xb_add(&bar[XB_TOPGEN], 1u);
            else XB_SPIN(xb_ld(&bar[XB_TOPGEN]) == tg, bar);
            __builtin_amdgcn_fence(__ATOMIC_ACQUIRE, "agent");
            xb_add(&bar[XB_XGEN(b.x)], 1u);
            asm volatile("s_waitcnt vmcnt(0)" ::: "memory");
        } else {
            XB_SPIN(xb_ld(&bar[XB_XGEN(b.x)]) == gen, bar);
            __builtin_amdgcn_fence(__ATOMIC_ACQUIRE, "agent");
            asm volatile("s_waitcnt vmcnt(0)" ::: "memory");
        }
    }
    __syncthreads();
}

#ifndef PHMASK
#define PHMASK 0xFFFFFFFFu
#endif
#ifndef REPMASK
#define REPMASK 0u
#endif
#define REP(k) for (int rep_ = 0; rep_ < 1 + (int)((REPMASK >> (k)) & 1u); ++rep_)
#define A (*kargs())
#define ws (kargs()->ws)
#define Wb ((const bf16*)(ws + WS_W))
#define XB ((bf16*)(ws + WS_XB))
#define CAT ((bf16*)(ws + WS_CAT))
#define HP ((bf16*)(ws + WS_HP))
#define Y ((bf16*)(ws + WS_Y))
#define X (kargs()->out)
#define lng (kargs()->in[5] + lnd(l) * 4096)
#define lnb (kargs()->in[6] + lnd(l) * 4096)
__global__ void __launch_bounds__(512, 2) mega_fwd(Args unused_args) {
    extern __shared__ __attribute__((aligned(16))) unsigned char lds_raw[];
    LAS unsigned char* lds = (LAS unsigned char*)lds_raw;
    cg::grid_group grid = cg::this_grid();
    { volatile LAS unsigned* bst = (volatile LAS unsigned*)(lds + LDS_BYTES - 64); if (tidx() < 16) bst[tidx()] = 0u; __syncthreads();
      (void)xcd_barrier_post((unsigned*)(ws), bst); }
    grid.sync();
#define GSYNC() do { XcdBarrier b_; b_.bar = (unsigned*)(ws); b_.x = xb_xcc_id(); b_.st = (volatile LAS unsigned*)(lds + LDS_BYTES - 64); xcd_barrier(b_); } while (0)
    prep0(A);
    for (int l = 0; l < 2; ++l) {
#if (PHMASK >> 0) & 1
        REP(0)
        layer_prep1(A, lds, l);
#endif
        GSYNC();
#if (PHMASK >> 1) & 1
        REP(1)
        s5_ktab(A, l);
#endif
#if (PHMASK >> 2) & 1
        REP(2)
        { EpiKV E{(bf16*)(ws + WS_KX), (bf16*)(ws + WS_VTX)}; run_gemm(lds, (const bf16*)(ws + WS_MEMB), Wb + WO_KV, 4096, 2048, 1024, 1024, 1024, E); }
#endif
        GSYNC();
#if (PHMASK >> 3) & 1
        REP(3)
        s5_fill(A, l);
#endif
#if (PHMASK >> 4) & 1
        REP(4)
        { const float* rs1_ = (const float*)(ws + (lnd(l) == 0 ? WS_RSTID : WS_RSTAT)); EpiSwiGLU E{HP, LnFold{rs1_, ((const float*)(ws + WS_CC) + (size_t)lnd(l) * CC_L + CC_GU1), ((const float*)(ws + WS_CC) + (size_t)lnd(l) * CC_L + CC_N + CC_GU1)}}; run_gemm<EpiSwiGLU, true>(lds, (const bf16*)Y, Wb + WO_GU1, MT, 5632, 1024, 1024, 1024, E); }
#endif
        GSYNC();
#if (PHMASK >> 5) & 1
        REP(5)
        { const bool first = lnd(l) == 0; const bf16* xr_ = (const bf16*)Y;   const float* rs_ = (const float*)(ws + (first ? WS_RSTID : WS_RSTAT));
          const float* g_ = first ? (const float*)(ws + WS_ONES) : kargs()->in[5] + 3 * 1024; const float* b_ = first ? (const float*)(ws + WS_ZEROS) : kargs()->in[6] + 3 * 1024;
          EpiResid E{xr_, Y, 0.5f, rs_, g_, b_, (float*)(ws + WS_STATP)}; run_gemm(lds, HP, Wb + WO_D1, MT, 1024, 2816, 2816, 2816, E); }
#endif
        GSYNC();
#if (PHMASK >> 6) & 1
        REP(6)
        stat_finalize((float*)(ws + WS_STATP), (float*)(ws + WS_RSTAT));
#endif
        GSYNC();
#if (PHMASK >> 7) & 1
        REP(7)
        { EpiProj E{HP, (bf16*)((unsigned char*)(kargs()->out) + OUT_VT), (bf16*)((unsigned char*)(kargs()->out) + OUT_SUX), (const float*)(ws + WS_ROPE), (const float*)(ws + WS_ROPE) + 4096 * 32, LnFold{(const float*)(ws + WS_RSTAT), ((const float*)(ws + WS_CC) + (size_t)lnd(l) * CC_L + CC_IN), ((const float*)(ws + WS_CC) + (size_t)lnd(l) * CC_L + CC_N + CC_IN)}, (float*)(ws + WS_GATES)}; run_gemm<EpiProj, true>(lds, (const bf16*)Y, Wb + WO_IN, MT, 3072, 1024, 1024, 1024, E); }
#endif
        GSYNC();
#if (PHMASK >> 8) & 1
        REP(8)
        diffattn_phase(A, lds, l);
#endif
#if (PHMASK >> 9) & 1
        REP(9)
        mlstm_local(A, lds, l);
#endif
#if (PHMASK >> 10) & 1
        REP(10)
        { pg8::Gemm g{(const bf16*)((unsigned char*)(kargs()->out) + OUT_SUX), (const bf16*)(ws + WS_EM), 16384, 4096, 1024, 1152, 1024}; GroupOrder S; S.init(16, 4, 1, gdim(), bidx()); EpiS5E E{(float*)(ws + WS_EOUT)};
          pg8::gemm_phase<EpiS5E, GroupOrder, true, true>(lds, g, S, E); }
#endif
        GSYNC();
#if (PHMASK >> 22) & 1
        mlstm_scan(A); s5_scan(A, l);
#endif
        GSYNC();
#if (PHMASK >> 11) & 1
        REP(11)
        mlstm_out(A, lds, l);
#endif
#if (PHMASK >> 12) & 1
        REP(12)
        { pg8::Gemm g{(const bf16*)((unsigned char*)(kargs()->out) + OUT_SUX), (const bf16*)(ws + WS_TF), 16384, 16384, 1152, 1152, 1152}; GroupOrder S; S.init(16, 4, 4, gdim(), bidx()); EpiS5Y E{(bf16*)((unsigned char*)(kargs()->out) + OUT_YS5)};
          pg8::gemm_phase<EpiS5Y, GroupOrder, true, true>(lds, g, S, E); }
#endif
        GSYNC();
#if (PHMASK >> 23) & 1
        REP(23)
        { EpiGLU E{(const bf16*)((unsigned char*)(kargs()->out) + OUT_YS5), A.in[23] + lnd(l) * 256, CAT}; run_gemm(lds, (const bf16*)((unsigned char*)(kargs()->out) + OUT_YS5), Wb + WO_GLU, MT, 256, 256, 256, 256, E); }
#endif
        GSYNC();
#if (PHMASK >> 13) & 1
        REP(13)
        { EpiResid E{Y, Y, 1.0f, (const float*)(float*)(ws + WS_RSTAT), lng, lnb, (float*)(ws + WS_STATP)}; run_gemm(lds, CAT, Wb + WO_OUT, MT, 1024, 1024, 1024, 1024, E); }
#endif
        GSYNC();
#if (PHMASK >> 14) & 1
        REP(14)
        stat_finalize((float*)(ws + WS_STATP), (float*)(ws + WS_RSTAT));
#endif
        GSYNC();
#if (PHMASK >> 15) & 1
        REP(15)
        { EpiBf16 E{HP, LnFold{(const float*)(ws + WS_RSTAT), ((const float*)(ws + WS_CC) + (size_t)lnd(l) * CC_L + CC_Q), ((const float*)(ws + WS_CC) + (size_t)lnd(l) * CC_L + CC_N + CC_Q)}}; run_gemm<EpiBf16, true>(lds, (const bf16*)Y, Wb + WO_Q, MT, 1024, 1024, 1024, 1024, E); }
#endif
        GSYNC();
#if (PHMASK >> 16) & 1
        REP(16)
        xattn_phase(A, lds);
#endif
        GSYNC();
#if (PHMASK >> 17) & 1
        REP(17)
        { EpiResid E{Y, Y, 1.0f, (const float*)(float*)(ws + WS_RSTAT), lng + 1024, lnb + 1024, (float*)(ws + WS_STATP)}; run_gemm(lds, (const bf16*)(ws + WS_HP + 128 * MiB), Wb + WO_O, MT, 1024, 1024, 1024, 1024, E); }
#endif
        GSYNC();
#if (PHMASK >> 18) & 1
        REP(18)
        stat_finalize((float*)(ws + WS_STATP), (float*)(ws + WS_RSTAT));
#endif
        GSYNC();
#if (PHMASK >> 19) & 1
        REP(19)
        { EpiSwiGLU E{HP, LnFold{(const float*)(ws + WS_RSTAT), ((const float*)(ws + WS_CC) + (size_t)lnd(l) * CC_L + CC_GU2), ((const float*)(ws + WS_CC) + (size_t)lnd(l) * CC_L + CC_N + CC_GU2)}}; run_gemm<EpiSwiGLU, true>(lds, (const bf16*)Y, Wb + WO_GU2, MT, 5632, 1024, 1024, 1024, E); }
#endif
        GSYNC();
#if (PHMASK >> 20) & 1
        REP(20)
        { EpiResid E{Y, Y, 0.5f, (const float*)(float*)(ws + WS_RSTAT), lng + 2048, lnb + 2048, (float*)(ws + WS_STATP)}; run_gemm(lds, HP, Wb + WO_D2, MT, 1024, 2816, 2816, 2816, E); }
#endif
        GSYNC();
#if (PHMASK >> 21) & 1
        REP(21)
        if (lnd(l) == 1) ln_phase(Y, lng + 3072, lnb + 3072, X, nullptr, nullptr, nullptr, (float*)(ws + WS_RSTAT));
        else stat_finalize((float*)(ws + WS_STATP), (float*)(ws + WS_RSTAT));
#endif
        GSYNC();
    }
}

#undef ws
#undef Wb
#undef XB
#undef CAT
#undef HP
#undef Y
#undef X
#undef lng
#undef lnb
#undef A
extern "C" void kernel_launch(void* const* d_in, const int* in_sizes, int n_in, void* d_out, int out_size, void* d_ws, size_t ws_size, hipStream_t stream) {
    static int grid = 0;
    if (grid == 0) {
        if (n_in != 28 || out_size != MT * DM || ws_size < WS_END) { fprintf(stderr, "kernel_launch: unexpected problem (n_in %d out %d ws %zu)\n", n_in, out_size, ws_size); grid = -1; return; }
        int dev = 0, cus = 0, per_cu = 0;
        hipGetDevice(&dev); hipDeviceGetAttribute(&cus, hipDeviceAttributeMultiprocessorCount, dev);
        hipFuncSetAttribute((const void*)mega_fwd, hipFuncAttributeMaxDynamicSharedMemorySize, LDS_BYTES);
        hipOccupancyMaxActiveBlocksPerMultiprocessor(&per_cu, (const void*)mega_fwd, 512, LDS_BYTES);
        if (per_cu < 1) per_cu = 1;
        (void)hipGetLastError();
        grid = cus * per_cu;
    }
    if (grid < 0) return;
    if (hipMemsetAsync(d_ws, 0, 327680, stream) != hipSuccess) { fprintf(stderr, "memset failed\n"); return; }
    Args a{};
    for (int i = 0; i < 28; ++i) a.in[i] = (const float*)d_in[i];
    a.out = (float*)d_out; a.ws = (unsigned char*)d_ws;
    void* args[] = {&a};
    hipError_t e = hipLaunchCooperativeKernel((const void*)mega_fwd, dim3(grid), dim3(512), args, LDS_BYTES, stream);
    if (e != hipSuccess) fprintf(stderr, "cooperative launch failed: %s (grid %d)\n", hipGetErrorString(e), grid);
}
```
